# Optimizing an MI355X kernel written in HIP

```python
import jax, jax.numpy as jnp
from jax import lax
import numpy as np

D_MODEL = 1024
BATCH = 8
SEQ = 4096
DEPTH = 2

N_EVEN = (DEPTH + 1) // 2
N_ODD = DEPTH // 2

CHUNK = 128
SGU_WIDTH = 2 * D_MODEL
SGU_GROUPS = 8
SGU_GROUP_DIM = SGU_WIDTH // SGU_GROUPS
RET_HEADS = 4
RET_DK = D_MODEL // RET_HEADS
RET_DV = 2 * RET_DK
RET_QK = RET_HEADS * RET_DK
RET_V = RET_HEADS * RET_DV
RET_IN = 2 * RET_QK + 2 * RET_V
ROPE_BASE = 10000.0
FFN_DIM = ((8 * D_MODEL // 3 + 127) // 128) * 128
N_EXPERTS = 8
TOP_K = 2
EPS = 1e-6

kernel_name = "hybrid_sgu_retention_moe_adaln"


def rmsnorm(x, g):
    xf = x.astype(jnp.float32)
    xf = xf * lax.rsqrt(jnp.mean(xf * xf, axis=-1, keepdims=True) + EPS)
    return (xf * g.astype(jnp.float32)).astype(x.dtype)


def layernorm(x, g, b):
    xf = x.astype(jnp.float32)
    mu = jnp.mean(xf, axis=-1, keepdims=True)
    var = jnp.mean(jnp.square(xf - mu), axis=-1, keepdims=True)
    y = (xf - mu) * lax.rsqrt(var + EPS) * g.astype(jnp.float32) + b.astype(jnp.float32)
    return y.astype(x.dtype)


def swiglu(h, w_gate_up, w_down):
    gu = h @ w_gate_up
    g, u = jnp.split(gu, 2, axis=-1)
    return (jax.nn.silu(g) * u) @ w_down


def chunked_sgu(h, w_in, ln_g, ln_b, w_s, b_s, w_out):
    bn, s, _ = h.shape
    nc = s // CHUNK
    z = jax.nn.gelu(h @ w_in)
    u, v = jnp.split(z, 2, axis=-1)
    v = layernorm(v, ln_g, ln_b)
    v = v.reshape(bn, nc, CHUNK, SGU_GROUPS, SGU_GROUP_DIM)
    mask = jnp.tril(jnp.ones((CHUNK, CHUNK), dtype=w_s.dtype))
    fv = jnp.einsum('gts,bnsgd->bntgd', w_s * mask, v) + b_s.T[:, :, None]
    y = u * fv.reshape(bn, s, SGU_WIDTH)
    return y @ w_out


def rope(t, positions):
    d = t.shape[-1]
    inv_freq = 1.0 / (ROPE_BASE ** (jnp.arange(0, d, 2, dtype=jnp.float32) / d))
    ang = positions.astype(jnp.float32)[..., None] * inv_freq
    cos = jnp.cos(ang)[:, :, None, :]
    sin = jnp.sin(ang)[:, :, None, :]
    tf = t.astype(jnp.float32)
    t1, t2 = jnp.split(tf, 2, axis=-1)
    return jnp.concatenate([t1 * cos - t2 * sin, t2 * cos + t1 * sin], axis=-1)


def retention(h, w_in, w_out, positions):
    bn, s, _ = h.shape
    nc = s // CHUNK
    proj = h @ w_in
    q, k, v, g = jnp.split(proj, [RET_QK, 2 * RET_QK, 2 * RET_QK + RET_V], axis=-1)
    q = rope(q.reshape(bn, s, RET_HEADS, RET_DK), positions)
    k = rope(k.reshape(bn, s, RET_HEADS, RET_DK), positions) * (RET_DK ** -0.5)
    v = v.reshape(bn, s, RET_HEADS, RET_DV).astype(jnp.float32)

    def to_chunks(t):
        return t.reshape(bn, nc, CHUNK, RET_HEADS, -1).transpose(1, 0, 3, 2, 4)

    qc, kc, vc = to_chunks(q), to_chunks(k), to_chunks(v)
    log_gamma = jnp.log1p(-jnp.exp2(-5.0 - jnp.arange(RET_HEADS, dtype=jnp.float32)))
    idx = jnp.arange(CHUNK, dtype=jnp.float32)
    rel = idx[:, None] - idx[None, :]
    intra = jnp.where(rel >= 0, jnp.exp(log_gamma[:, None, None] * jnp.maximum(rel, 0.0)), 0.0)
    xi = jnp.exp(log_gamma[:, None] * (idx + 1.0))[None, :, :, None]
    zeta = jnp.exp(log_gamma[:, None] * (CHUNK - 1.0 - idx))[None, :, :, None]
    chunk_decay = jnp.exp(log_gamma * CHUNK)[None, :, None, None]

    def step(state, qkv):
        qi, ki, vi = qkv
        scores = jnp.einsum('bhtd,bhsd->bhts', qi, ki) * intra
        o = (jnp.einsum('bhts,bhsv->bhtv', scores, vi)
             + jnp.einsum('bhtd,bhdv->bhtv', qi, state) * xi)
        state = state * chunk_decay + jnp.einsum('bhsd,bhsv->bhdv', ki, vi * zeta)
        return state, o

    state0 = jnp.zeros((bn, RET_HEADS, RET_DK, RET_DV), jnp.float32)
    _, o = lax.scan(step, state0, (qc, kc, vc))
    o = o.transpose(1, 0, 3, 2, 4).reshape(bn, s, RET_HEADS, RET_DV)
    o = o * lax.rsqrt(jnp.mean(o * o, axis=-1, keepdims=True) + EPS)
    o = o.reshape(bn, s, RET_V).astype(h.dtype) * jax.nn.silu(g)
    return o @ w_out


def moe_swiglu(h, w_router, b_router, w_gate_up, w_down):
    bn, s, dm = h.shape
    t = h.reshape(-1, dm)
    logits = (t @ w_router).astype(jnp.float32) + b_router.astype(jnp.float32)
    top_v, top_i = lax.top_k(logits, TOP_K)
    wts = jax.nn.softmax(top_v, axis=-1)
    gates = jnp.sum(jax.nn.one_hot(top_i, N_EXPERTS, dtype=jnp.float32) * wts[..., None], axis=1)
    gates = gates.astype(h.dtype)
    y = jnp.zeros_like(t)
    for e in range(N_EXPERTS):
        y = y + gates[:, e:e + 1] * swiglu(t, w_gate_up[e], w_down[e])
    return y.reshape(bn, s, dm)


def setup_inputs(seed: int = 0) -> dict:
    key = jax.random.key(seed)
    ks = jax.random.split(key, 24)

    def nrm(k, shape, std):
        return jax.random.normal(k, shape, jnp.float32) * std

    D = D_MODEL
    x = nrm(ks[0], (BATCH, SEQ, D), 1.0)
    c = nrm(ks[1], (BATCH, D), 1.0)
    offs = jax.random.randint(ks[2], (BATCH, 1), 0, 1024, dtype=jnp.int32)
    positions = jnp.arange(SEQ, dtype=jnp.int32)[None, :] + offs
    return {
        "x": x,
        "c": c,
        "positions": positions,
        "ada_w": nrm(ks[3], (DEPTH, D, 6 * D), 0.5 * D ** -0.5),
        "ada_b": nrm(ks[4], (DEPTH, 6 * D), 0.02),
        "mix_norm_g": 1.0 + nrm(ks[5], (DEPTH, D), 0.02),
        "ffn_norm_g": 1.0 + nrm(ks[6], (DEPTH, D), 0.02),
        "sgu_w_in": nrm(ks[7], (N_EVEN, D, 2 * SGU_WIDTH), D ** -0.5),
        "sgu_ln_g": 1.0 + nrm(ks[8], (N_EVEN, SGU_WIDTH), 0.02),
        "sgu_ln_b": nrm(ks[9], (N_EVEN, SGU_WIDTH), 0.02),
        "sgu_w_s": nrm(ks[10], (N_EVEN, SGU_GROUPS, CHUNK, CHUNK), 0.5 * CHUNK ** -0.5),
        "sgu_b_s": 1.0 + nrm(ks[11], (N_EVEN, SGU_GROUPS, CHUNK), 0.1),
        "sgu_w_out": nrm(ks[12], (N_EVEN, SGU_WIDTH, D), SGU_WIDTH ** -0.5),
        "ffn_w_gate_up": nrm(ks[13], (N_EVEN, D, 2 * FFN_DIM), D ** -0.5),
        "ffn_w_down": nrm(ks[14], (N_EVEN, FFN_DIM, D), FFN_DIM ** -0.5),
        "ret_w_in": nrm(ks[15], (N_ODD, D, RET_IN), D ** -0.5),
        "ret_w_out": nrm(ks[16], (N_ODD, RET_V, D), RET_V ** -0.5),
        "moe_w_router": nrm(ks[17], (N_ODD, D, N_EXPERTS), D ** -0.5),
        "moe_b_router": nrm(ks[18], (N_ODD, N_EXPERTS), 0.01),
        "moe_w_gate_up": nrm(ks[19], (N_ODD, N_EXPERTS, D, 2 * FFN_DIM), D ** -0.5),
        "moe_w_down": nrm(ks[20], (N_ODD, N_EXPERTS, FFN_DIM, D), FFN_DIM ** -0.5),
        "final_norm_g": 1.0 + nrm(ks[21], (D,), 0.02),
    }


def reference(x, c, positions, ada_w, ada_b, mix_norm_g, ffn_norm_g,
              sgu_w_in, sgu_ln_g, sgu_ln_b, sgu_w_s, sgu_b_s, sgu_w_out,
              ffn_w_gate_up, ffn_w_down, ret_w_in, ret_w_out,
              moe_w_router, moe_b_router, moe_w_gate_up, moe_w_down,
              final_norm_g):
    sc = jax.nn.silu(c)
    for i in range(DEPTH):
        j = i // 2
        mod = sc @ ada_w[i] + ada_b[i]
        sh1, s1, g1, sh2, s2, g2 = [m[:, None, :] for m in jnp.split(mod, 6, axis=-1)]
        h = rmsnorm(x, mix_norm_g[i]) * (1.0 + s1) + sh1
        if i % 2 == 0:
            y = chunked_sgu(h, sgu_w_in[j], sgu_ln_g[j], sgu_ln_b[j],
                            sgu_w_s[j], sgu_b_s[j], sgu_w_out[j])
        else:
            y = retention(h, ret_w_in[j], ret_w_out[j], positions)
        x = x + g1 * y
        h = rmsnorm(x, ffn_norm_g[i]) * (1.0 + s2) + sh2
        if i % 2 == 0:
            y = swiglu(h, ffn_w_gate_up[j], ffn_w_down[j])
        else:
            y = moe_swiglu(h, moe_w_router[j], moe_b_router[j],
                           moe_w_gate_up[j], moe_w_down[j])
        x = x + g2 * y
    return rmsnorm(x, final_norm_g)
```

```cpp
#include <hip/hip_runtime.h>
#include <cstdio>
#include <cstdint>

constexpr int D = 1024, NB = 8, SEQ = 4096, M = NB * SEQ;
constexpr int CH = 128, SGW = 2048, NGRP = 8;
constexpr int RH = 4, RDK = 256, RDV = 512, RET_IN = 6144;
constexpr int FF = 2816, NE = 8;
constexpr float EPS = 1e-6f;
constexpr int MODW = 6 * D;
constexpr int LCAP = 2 * M + NE * 256;
constexpr int LTILES = LCAP / 256;

typedef unsigned short bf16;
#define LAS __attribute__((address_space(3)))
#define GAS __attribute__((address_space(1)))
__device__ __forceinline__ float shx(float v, int k, int lane) { return __builtin_bit_cast(float, __builtin_amdgcn_ds_bpermute((lane ^ k) << 2, __builtin_bit_cast(int, v))); }

__device__ __forceinline__ int fresh_lane() { int l; asm volatile("v_mbcnt_lo_u32_b32 %0, -1, 0\n\tv_mbcnt_hi_u32_b32 %0, -1, %0" : "=v"(l)); return l; }
namespace pg8 {
#define PG8_LAS __attribute__((address_space(3)))
constexpr int EPI_SLOT_OFF = 131072 + 1024;
typedef unsigned short bf16_t;
typedef short bf16x8 __attribute__((ext_vector_type(8)));
typedef float f32x4 __attribute__((ext_vector_type(4)));
typedef unsigned u32x4 __attribute__((ext_vector_type(4)));
typedef unsigned u32x2 __attribute__((ext_vector_type(2)));
constexpr int BM = 256, BK = 64, HALF = 128, HTB = HALF * BK * 2, STAGE_BYTES = 8 * HTB, NXCD = 8, WGM = 4;

__host__ __device__ __forceinline__ int lds_byte(int r, int c) { const int st = (r >> 4) * 2 + (c >> 5), rr = r & 15, cc = c & 31, ob = rr * 64 + cc * 2; return st * 1024 + (ob ^ (((ob >> 9) & 1) << 5)); }
__host__ __device__ __forceinline__ void stage_rc(int b, int& R, int& C) { const int st = b / 1024, sb = b % 1024, swz = sb ^ (((sb >> 9) & 1) << 5); R = (st >> 1) * 16 + swz / 64; C = (st & 1) * 32 + (swz % 64) / 2; }
__host__ __device__ __forceinline__ int perm32(int rho) { const int n = rho >> 4, i = rho & 15; return 8 * (i >> 2) + 4 * n + (i & 3); }

struct Unit { int pm, pn, pb; };
struct Gemm { const bf16_t* A; const bf16_t* Bt; int K; };

struct StaticOrder {
    int nM, nN, nwg, G, c; const int* tile_e; const int* rowmap;
    __device__ void init(int nM_, int nN_, int G_, int c_, const int* te, const int* rm) { nM = nM_; nN = nN_; nwg = nM * nN; G = G_; c = c_; tile_e = te; rowmap = rm; }
    __device__ bool next(int i, Unit& u) const {
        const long L = (long)i * G + c; if (L >= nwg) return false;
        int wgid = (int)L; { const int q = nwg / NXCD, r = nwg % NXCD, xcd = wgid % NXCD, off = wgid / NXCD; wgid = (xcd < r ? xcd * (q + 1) : r * (q + 1) + (xcd - r) * q) + off; }
        const int nig = WGM * nN, gid = wgid / nig, fm = gid * WGM, gsz = (nM - fm) < WGM ? (nM - fm) : WGM;
        u.pm = fm + ((wgid % nig) % gsz); u.pn = (wgid % nig) / gsz;
        u.pb = tile_e ? __builtin_amdgcn_readfirstlane(tile_e[u.pm]) * nN + u.pn : u.pn; return true;
    }
};

__device__ __forceinline__ unsigned cvt_pk_bf16(float lo, float hi) { unsigned r; asm volatile("v_cvt_pk_bf16_f32 %0, %1, %2" : "=v"(r) : "v"(lo), "v"(hi)); return r; }

typedef int i32x4 __attribute__((ext_vector_type(4)));
typedef int i32x8 __attribute__((ext_vector_type(8)));
typedef short bf16x16 __attribute__((ext_vector_type(16)));
#ifndef F8SCALE
#define F8SCALE 0
#endif
template <bool I8> struct AccT { typedef f32x4 type; };
template <> struct AccT<true> { typedef i32x4 type; };
template <class Epi, class Sched, bool ALIGN_EPI, bool GATHER, bool I8 = false, bool F8 = false>
__device__ __forceinline__ void gemm_phase(PG8_LAS unsigned char* lds, const Gemm g, const Sched& S, const Epi& E, int tid_) {
    asm volatile("" : "+v"(tid_));
    const int tid = tid_, wid = __builtin_amdgcn_readfirstlane(tid >> 6), lane = tid & 63, wr = wid >> 2, wc = wid & 3, fr = lane & 15, fq = lane >> 4;
    const int K = (I8 || F8) ? g.K : 2 * g.K  , nt = K / 128;
    int R0, C0; stage_rc(tid * 16, R0, C0); C0 *= 2;
    unsigned voffB[2];
    { const int Rb = Epi::PERM ? ((R0 & ~31) + perm32(R0 & 31)) : R0; voffB[0] = (unsigned)(Rb * K + C0); voffB[1] = voffB[0] + (unsigned)(64 * K); }
    const size_t kstep = (size_t)128;
    const size_t hstep = (size_t)HALF * K;
    const size_t tstep = 2 * hstep;
    const unsigned ldsw = (unsigned)wid * 1024u;
    const int aoff = lds_byte(wr * 64 + fr, fq * 8), boff = lds_byte(wc * 32 + fr, fq * 8);
#define PG8_SA(b, h) (((b) * 2 + (h)) * HTB)
#define PG8_SB(b, h) ((4 + (b) * 2 + (h)) * HTB)
#define PG8_STAGE(bufoff, gbase, voff) do { _Pragma("unroll") for (int _i = 0; _i < 2; ++_i) \
        __builtin_amdgcn_global_load_lds((const unsigned*)((const char*)(gbase) + (voff)[_i]), (PG8_LAS unsigned*)(lds + (bufoff) + ldsw + _i * 8192), 16, 0, 0); } while (0)
#define PG8_LDA(dst, b, h) do { if constexpr (F8) { _Pragma("unroll") for (int m = 0; m < 4; ++m) dst##x[m] = __builtin_shufflevector(*(const PG8_LAS bf16x8*)(lds + PG8_SA(b, h) + aoff + m * 2048), *(const PG8_LAS bf16x8*)(lds + PG8_SA(b, h) + aoff + m * 2048 + 1024), 0, 1, 2, 3, 4, 5, 6, 7, 8, 9, 10, 11, 12, 13, 14, 15); } \
        else { _Pragma("unroll") for (int m = 0; m < 4; ++m) _Pragma("unroll") for (int k = 0; k < 2; ++k) dst[m][k] = *(const PG8_LAS bf16x8*)(lds + PG8_SA(b, h) + aoff + m * 2048 + k * 1024); } } while (0)
#define PG8_LDB(dst, b, h) do { if constexpr (F8) { _Pragma("unroll") for (int n = 0; n < 2; ++n) dst##x[n] = __builtin_shufflevector(*(const PG8_LAS bf16x8*)(lds + PG8_SB(b, h) + boff + n * 2048), *(const PG8_LAS bf16x8*)(lds + PG8_SB(b, h) + boff + n * 2048 + 1024), 0, 1, 2, 3, 4, 5, 6, 7, 8, 9, 10, 11, 12, 13, 14, 15); } \
        else { _Pragma("unroll") for (int n = 0; n < 2; ++n) _Pragma("unroll") for (int k = 0; k < 2; ++k) dst[n][k] = *(const PG8_LAS bf16x8*)(lds + PG8_SB(b, h) + boff + n * 2048 + k * 1024); } } while (0)
#define PG8_MMA(ai, bj, At, Bt) do { __builtin_amdgcn_s_setprio(1); \
        if constexpr (F8) { _Pragma("unroll") for (int m = 0; m < 4; ++m) _Pragma("unroll") for (int n = 0; n < 2; ++n) \
            acc[ai][bj][m][n] = __builtin_amdgcn_mfma_scale_f32_16x16x128_f8f6f4(__builtin_bit_cast(i32x8, Bt##x[n]), __builtin_bit_cast(i32x8, At##x[m]), acc[ai][bj][m][n], 0, 0, 0, F8SCALE, 0, F8SCALE); } \
        else _Pragma("unroll") for (int m = 0; m < 4; ++m) _Pragma("unroll") for (int n = 0; n < 2; ++n) _Pragma("unroll") for (int k = 0; k < 2; ++k) { \
        if constexpr (I8) acc[ai][bj][m][n] = __builtin_amdgcn_mfma_i32_16x16x64_i8(__builtin_bit_cast(i32x4, Bt[n][k]), __builtin_bit_cast(i32x4, At[m][k]), acc[ai][bj][m][n], 0, 0, 0); \
        else acc[ai][bj][m][n] = __builtin_amdgcn_mfma_f32_16x16x32_bf16(Bt[n][k], At[m][k], acc[ai][bj][m][n], 0, 0, 0); } __builtin_amdgcn_s_setprio(0); } while (0)
#define PG8_WAIT_V(n) asm volatile("s_waitcnt vmcnt(" #n ")" ::: "memory")
#define PG8_WAIT_L(n) asm volatile("s_waitcnt lgkmcnt(" #n ")" ::: "memory")
#define PG8_WAIT_VR(rf) asm volatile("s_cmp_lg_u32 %0, 0\n\ts_cbranch_scc1 1f\n\ts_waitcnt vmcnt(8)\n\ts_branch 2f\n1:\n\ts_waitcnt vmcnt(%1)\n2:" :: "s"(rf), "n"(8 + Epi::NSTORE) : "memory", "scc")
#define PG8_BAR __builtin_amdgcn_s_barrier()
#define PG8_SCHED __builtin_amdgcn_sched_barrier(0)
#define PG8_AOFF(dst, u) do { _Pragma("unroll") for (int _h = 0; _h < 2; ++_h) _Pragma("unroll") for (int _i = 0; _i < 2; ++_i) { \
        int _row = (u).pm * BM + _h * HALF + R0 + 64 * _i; if (GATHER) { const int _t = S.rowmap[_row]; _row = _t < 0 ? 0 : (_t >> 1); } \
        dst[_h][_i] = (unsigned)_row * (unsigned)K + (unsigned)C0; } } while (0)
    Unit cur, nxt; int ui = 0;
    if (!S.next(0, cur)) return;
    cur.pm = __builtin_amdgcn_readfirstlane(cur.pm); cur.pn = __builtin_amdgcn_readfirstlane(cur.pn); cur.pb = __builtin_amdgcn_readfirstlane(cur.pb);
    typedef typename AccT<I8>::type acc_t;
    acc_t acc[2][2][4][2];
#pragma unroll
    for (int a = 0; a < 2; ++a)
#pragma unroll
        for (int b = 0; b < 2; ++b)
#pragma unroll
            for (int m = 0; m < 4; ++m)
#pragma unroll
                for (int n = 0; n < 2; ++n) acc[a][b][m][n] = (acc_t){0, 0, 0, 0};
    bf16x8 At[4][2], B0[2][2], B1[2][2]; bf16x16 Atx[4], B0x[2], B1x[2];
    unsigned oA[2][2]; PG8_AOFF(oA, cur);
    PG8_LAS unsigned char* const eslot = lds + EPI_SLOT_OFF + wid * 768;
    if constexpr (I8 && Epi::RAW) E.pre_dma(cur, wid, wr, wc, lane, eslot);
    const char* Ab = (const char*)g.A; const char* cB = (const char*)g.Bt + (size_t)cur.pb * tstep;
    PG8_STAGE(PG8_SB(0, 0), cB, voffB); PG8_STAGE(PG8_SB(0, 1), cB + hstep, voffB); PG8_STAGE(PG8_SA(0, 0), Ab, oA[0]); PG8_STAGE(PG8_SA(0, 1), Ab, oA[1]);
    if (wr == 1) PG8_BAR;
    PG8_WAIT_V(2); PG8_BAR;
    PG8_STAGE(PG8_SB(1, 0), cB + kstep, voffB); PG8_STAGE(PG8_SA(1, 0), Ab + kstep, oA[0]); PG8_STAGE(PG8_SB(1, 1), cB + hstep + kstep, voffB);
    PG8_WAIT_V(6); PG8_BAR;
    for (;;) {
        const bool has_next = __builtin_amdgcn_readfirstlane((int)S.next(ui + 1, nxt)) != 0;
        nxt.pm = __builtin_amdgcn_readfirstlane(nxt.pm); nxt.pn = __builtin_amdgcn_readfirstlane(nxt.pn); nxt.pb = __builtin_amdgcn_readfirstlane(nxt.pb);
        const char* nB = has_next ? (const char*)g.Bt + (size_t)nxt.pb * tstep : cB;
        for (int t = 0; t < nt; t += 2) {
            const bool last = (t == nt - 2);
            const bool sw = last && has_next;
            const char* a1 = Ab + (size_t)(t + 1) * kstep;
            const char* a2 = last ? Ab : Ab + (size_t)(t + 2) * kstep; const char* b2 = last ? nB : cB + (size_t)(t + 2) * kstep;
            const char* a3 = a2 + kstep; const char* b3 = b2 + kstep;
            unsigned nO[2][2];
            if (sw) { PG8_AOFF(nO, nxt); }
            const int relax = __builtin_amdgcn_readfirstlane((t == 0 && ui > 0) ? 1 : 0);
            PG8_LDB(B0, 0, 0); PG8_LDB(B1, 0, 1); PG8_SCHED; PG8_LDA(At, 0, 0); PG8_STAGE(PG8_SA(1, 1), a1, oA[1]);
            PG8_WAIT_VR(relax); PG8_WAIT_L(0); PG8_BAR; PG8_MMA(0, 0, At, B0); PG8_MMA(0, 1, At, B1); PG8_BAR; PG8_SCHED;
            if (sw) { oA[0][0] = nO[0][0]; oA[0][1] = nO[0][1]; oA[1][0] = nO[1][0]; oA[1][1] = nO[1][1]; }
            PG8_LDA(At, 0, 1); PG8_STAGE(PG8_SB(0, 0), b2, voffB); PG8_STAGE(PG8_SB(0, 1), b2 + hstep, voffB); PG8_STAGE(PG8_SA(0, 0), a2, oA[0]);
            PG8_WAIT_VR(relax); PG8_WAIT_L(0); PG8_BAR; PG8_MMA(1, 0, At, B0); PG8_MMA(1, 1, At, B1); PG8_BAR; PG8_SCHED;
            PG8_LDB(B0, 1, 0); PG8_LDB(B1, 1, 1); PG8_SCHED; PG8_LDA(At, 1, 0); PG8_STAGE(PG8_SA(0, 1), a2, oA[1]);
            PG8_WAIT_V(8); PG8_WAIT_L(0); PG8_BAR; PG8_MMA(0, 0, At, B0); PG8_MMA(0, 1, At, B1); PG8_BAR; PG8_SCHED;
            PG8_LDA(At, 1, 1); PG8_STAGE(PG8_SB(1, 0), b3, voffB); PG8_STAGE(PG8_SB(1, 1), b3 + hstep, voffB); PG8_STAGE(PG8_SA(1, 0), a3, oA[0]);
            PG8_WAIT_V(8); PG8_WAIT_L(0); PG8_BAR; PG8_MMA(1, 0, At, B0); PG8_MMA(1, 1, At, B1); PG8_BAR; PG8_SCHED;
        }
        if constexpr (ALIGN_EPI) { if (wr == 0) PG8_BAR; }
        if constexpr (F8) {
            { const int le_ = fresh_lane(); E(acc, cur, wr, wc, le_ & 15, le_ >> 4); }
        } else if constexpr (I8) {
            static_assert(!I8 || Epi::PERM, "int8 dequant assumes the PERM column layout");
            if constexpr (Epi::RAW) {
                float csa[2][4]; f32x4 csw[2][2];
                E.pre_read(eslot, fr, fq, csa, csw); PG8_WAIT_L(0);
                { Unit pu; pu.pm = has_next ? nxt.pm : cur.pm; pu.pn = has_next ? nxt.pn : cur.pn; pu.pb = has_next ? nxt.pb : cur.pb; E.pre_dma(pu, wid, wr, wc, lane, eslot); }
                E.raw(acc, cur, wr, wc, fr, fq, csa, csw); } else {
            f32x4 accf[2][2][4][2]; f32x4 swv[2][2];
            const float* swp = E.sw + (size_t)cur.pb * BM + wc * 32 + 8 * fq;
#pragma unroll
            for (int bj = 0; bj < 2; ++bj)
#pragma unroll
                for (int n = 0; n < 2; ++n) swv[bj][n] = *(const f32x4*)(swp + bj * HALF + 4 * n);
#pragma unroll
            for (int ai = 0; ai < 2; ++ai)
#pragma unroll
                for (int m = 0; m < 4; ++m) { int row = cur.pm * BM + ai * HALF + wr * 64 + m * 16 + fr; if (GATHER) { const int t_ = S.rowmap[row]; row = t_ < 0 ? 0 : (t_ >> 1); } const float sa = E.sa[row];
#pragma unroll
                    for (int bj = 0; bj < 2; ++bj)
#pragma unroll
                        for (int n = 0; n < 2; ++n)
#pragma unroll
                            for (int e = 0; e < 4; ++e) accf[ai][bj][m][n][e] = (float)acc[ai][bj][m][n][e] * (sa * swv[bj][n][e]); }
            E(accf, cur, wr, wc, fr, fq); }
        } else {
            E(acc, cur, wr, wc, fr, fq);
        }
        if (!has_next) break;
#pragma unroll
        for (int a = 0; a < 2; ++a)
#pragma unroll
            for (int b = 0; b < 2; ++b)
#pragma unroll
                for (int m = 0; m < 4; ++m)
#pragma unroll
                    for (int n = 0; n < 2; ++n) acc[a][b][m][n] = (acc_t){0, 0, 0, 0};
        cur = nxt; cB = nB; ++ui;
        if constexpr (ALIGN_EPI) { if (wr == 1) PG8_BAR; }
    }
    PG8_WAIT_V(0);
    if constexpr (!ALIGN_EPI) { if (wr == 0) PG8_BAR; }
    PG8_BAR;
#undef PG8_SA
#undef PG8_SB
#undef PG8_STAGE
#undef PG8_LDA
#undef PG8_LDB
#undef PG8_MMA
#undef PG8_WAIT_V
#undef PG8_WAIT_L
#undef PG8_WAIT_VR
#undef PG8_BAR
#undef PG8_SCHED
#undef PG8_AOFF
}

__device__ __forceinline__ float silu_f(float x) { return x * __builtin_amdgcn_rcpf(1.0f + __builtin_amdgcn_exp2f(-1.44269504f * x)); }
__device__ __forceinline__ float gelu_f(float x) { const float t = x * x; const float a = x * (2.30220819f + 0.10294324f * t); return x * __builtin_amdgcn_rcpf(1.0f + __builtin_amdgcn_exp2f(-a)); }

struct EpiSguIn {
    static constexpr bool PERM = true; static constexpr bool RAW = false; static constexpr int NSTORE = 16;
    bf16_t* U; bf16_t* V; float2* vstat; const float* sa; const float* sw;
    __device__ __forceinline__ void operator()(const f32x4 (&acc)[2][2][4][2], const Unit& u, int wr, int wc, int fr, int fq) const {
        const int row0 = u.pm * BM + wr * 64 + fr; const bool isV = u.pn >= 8; bf16_t* base = isV ? V : U;
        const int col0 = (u.pn & 7) * BM + wc * 32 + 8 * fq;
#pragma unroll
        for (int ai = 0; ai < 2; ++ai)
#pragma unroll
            for (int m = 0; m < 4; ++m) { const int row = row0 + ai * HALF + m * 16; bf16_t* rowp = base + (size_t)row * SGW + col0; float s = 0.f, q = 0.f;
#pragma unroll
                for (int bj = 0; bj < 2; ++bj) { f32x4 v0 = acc[ai][bj][m][0], v1 = acc[ai][bj][m][1];
                    if (isV) {
#pragma unroll
                        for (int e = 0; e < 4; ++e) { v0[e] = gelu_f(v0[e]); v1[e] = gelu_f(v1[e]); s += v0[e] + v1[e]; q += v0[e] * v0[e] + v1[e] * v1[e]; } }
                    u32x4 w; w.x = cvt_pk_bf16(v0[0], v0[1]); w.y = cvt_pk_bf16(v0[2], v0[3]); w.z = cvt_pk_bf16(v1[0], v1[1]); w.w = cvt_pk_bf16(v1[2], v1[3]);
                    *(u32x4*)(rowp + bj * HALF) = w; }
                if (isV) { const int ln = fq * 16 + fr; s += shx(s, 16, ln); s += shx(s, 32, ln); q += shx(q, 16, ln); q += shx(q, 32, ln);
                    if (fq == 0) vstat[(size_t)row * 32 + (u.pn - 8) * 4 + wc] = make_float2(s, q); } }
    }
};
struct EpiDelta {
    static constexpr bool PERM = true; static constexpr bool RAW = false; static constexpr int NSTORE = 16;
    bf16_t* out; const float* gate; const float* sa; const float* sw;
    __device__ __forceinline__ void operator()(const f32x4 (&acc)[2][2][4][2], const Unit& u, int wr, int wc, int fr, int fq) const {
        const int row0 = u.pm * BM + wr * 64 + fr, col0 = u.pn * BM + wc * 32 + 8 * fq; const int b = (u.pm * BM) / SEQ;
        f32x4 gv[2][2];
#pragma unroll
        for (int bj = 0; bj < 2; ++bj)
#pragma unroll
            for (int n = 0; n < 2; ++n) gv[bj][n] = *(const f32x4*)(gate + (size_t)b * MODW + col0 + bj * HALF + 4 * n);
#pragma unroll
        for (int ai = 0; ai < 2; ++ai)
#pragma unroll
            for (int m = 0; m < 4; ++m) { bf16_t* rowp = out + (size_t)(row0 + ai * HALF + m * 16) * D + col0;
#pragma unroll
                for (int bj = 0; bj < 2; ++bj) { const f32x4 a0 = acc[ai][bj][m][0] * gv[bj][0], a1 = acc[ai][bj][m][1] * gv[bj][1];
                    u32x4 o; o.x = cvt_pk_bf16(a0[0], a0[1]); o.y = cvt_pk_bf16(a0[2], a0[3]); o.z = cvt_pk_bf16(a1[0], a1[1]); o.w = cvt_pk_bf16(a1[2], a1[3]); *(u32x4*)(rowp + bj * HALF) = o; } }
    }
};
struct EpiDeltaF8 {
    static constexpr bool PERM = true; static constexpr bool RAW = false; static constexpr int NSTORE = 16;
    bf16_t* out; const float* gate; const float* sw; float f8s;
    __device__ __forceinline__ void operator()(const f32x4 (&acc)[2][2][4][2], const Unit& u, int wr, int wc, int fr, int fq) const {
        const int row0 = u.pm * BM + wr * 64 + fr, col0 = u.pn * BM + wc * 32 + 8 * fq; const int b = (u.pm * BM) / SEQ;
#pragma unroll
        for (int bj = 0; bj < 2; ++bj) { const float* gp = gate + (size_t)b * MODW + col0 + bj * HALF; const float* sp = sw + (size_t)u.pb * BM + wc * 32 + 8 * fq + bj * HALF;
            const f32x4 g0 = *(const f32x4*)gp * *(const f32x4*)sp * f8s, g1 = *(const f32x4*)(gp + 4) * *(const f32x4*)(sp + 4) * f8s;
#pragma unroll
            for (int ai = 0; ai < 2; ++ai)
#pragma unroll
                for (int m = 0; m < 4; ++m) { bf16_t* rowp = out + (size_t)(row0 + ai * HALF + m * 16) * D + col0 + bj * HALF; const f32x4 a0 = acc[ai][bj][m][0] * g0, a1 = acc[ai][bj][m][1] * g1;
                    u32x4 o; o.x = cvt_pk_bf16(a0[0], a0[1]); o.y = cvt_pk_bf16(a0[2], a0[3]); o.z = cvt_pk_bf16(a1[0], a1[1]); o.w = cvt_pk_bf16(a1[2], a1[3]); *(u32x4*)rowp = o; } }
    }
};
struct EpiSwiglu {
    static constexpr bool PERM = true; static constexpr bool RAW = false;
    bf16_t* O; int ldc; const float* sa; const float* sw;
    __device__ __forceinline__ void operator()(const f32x4 (&acc)[2][2][4][2], const Unit& u, int wr, int wc, int fr, int fq) const {
        const int row0 = u.pm * BM + wr * 64 + fr, col0 = u.pn * HALF + wc * 32 + 8 * fq;
#pragma unroll
        for (int ai = 0; ai < 2; ++ai)
#pragma unroll
            for (int m = 0; m < 4; ++m) { bf16_t* rowp = O + (size_t)(row0 + ai * HALF + m * 16) * ldc + col0;
                f32x4 v0, v1;
#pragma unroll
                for (int e = 0; e < 4; ++e) { v0[e] = silu_f(acc[ai][0][m][0][e]) * acc[ai][1][m][0][e]; v1[e] = silu_f(acc[ai][0][m][1][e]) * acc[ai][1][m][1][e]; }
                u32x4 w; w.x = cvt_pk_bf16(v0[0], v0[1]); w.y = cvt_pk_bf16(v0[2], v0[3]); w.z = cvt_pk_bf16(v1[0], v1[1]); w.w = cvt_pk_bf16(v1[2], v1[3]);
                *(u32x4*)rowp = w; }
    }
};
constexpr float ACT_F8 = 4.0f;
__device__ __forceinline__ unsigned pk4_fp8(float a, float b, float c, float d) {
    a = __builtin_fminf(__builtin_fmaxf(a, -448.f), 448.f); b = __builtin_fminf(__builtin_fmaxf(b, -448.f), 448.f); c = __builtin_fminf(__builtin_fmaxf(c, -448.f), 448.f); d = __builtin_fminf(__builtin_fmaxf(d, -448.f), 448.f);
    unsigned w = 0u; w = __builtin_amdgcn_cvt_pk_fp8_f32(a, b, w, false); w = __builtin_amdgcn_cvt_pk_fp8_f32(c, d, w, true); return w; }
struct EpiSwigluF8 {
    static constexpr bool PERM = true; static constexpr bool RAW = true; static constexpr int NSTORE = 8;
    unsigned char* O; int ldc; const float* sa; const float* sw;
    __device__ __forceinline__ void pre_dma(const Unit& u, int wid, int wr, int wc, int lane, PG8_LAS unsigned char* slot) const {
        const float* sap = sa + u.pm * BM + wr * 64 + lane; const float* swp = sw + (size_t)u.pb * BM + wc * 32 + (lane & 31) + (lane >> 5) * HALF;
        __builtin_amdgcn_global_load_lds((const unsigned*)sap, (PG8_LAS unsigned*)slot, 4, 0, 0);
        __builtin_amdgcn_global_load_lds((const unsigned*)(sap + HALF), (PG8_LAS unsigned*)(slot + 256), 4, 0, 0);
        __builtin_amdgcn_global_load_lds((const unsigned*)swp, (PG8_LAS unsigned*)(slot + 512), 4, 0, 0);
        (void)wid;
    }
    __device__ __forceinline__ void pre_read(PG8_LAS unsigned char* slot, int fr, int fq, float (&psa)[2][4], f32x4 (&psw)[2][2]) const {
        const PG8_LAS float* rp = (const PG8_LAS float*)slot;
#pragma unroll
        for (int ai = 0; ai < 2; ++ai)
#pragma unroll
            for (int m = 0; m < 4; ++m) psa[ai][m] = rp[ai * 64 + m * 16 + fr];
#pragma unroll
        for (int n = 0; n < 2; ++n) { psw[0][n] = *(const PG8_LAS f32x4*)(rp + 128 + 8 * fq + 4 * n); psw[1][n] = *(const PG8_LAS f32x4*)(rp + 160 + 8 * fq + 4 * n); }
    }
    __device__ __forceinline__ void raw(const i32x4 (&acc)[2][2][4][2], const Unit& u, int wr, int wc, int fr, int fq, const float (&sav)[2][4], const f32x4 (&swv)[2][2]) const {
        const int row0 = u.pm * BM + wr * 64 + fr, col0 = u.pn * HALF + wc * 32 + 8 * fq;
        f32x4 cg[2], cw[2];
#pragma unroll
        for (int n = 0; n < 2; ++n) { const f32x4 sg = swv[0][n], su = swv[1][n];
#pragma unroll
            for (int e = 0; e < 4; ++e) { cg[n][e] = -1.44269504f * sg[e]; cw[n][e] = sg[e] * su[e] * ACT_F8; } }
#pragma unroll
        for (int ai = 0; ai < 2; ++ai)
#pragma unroll
            for (int m = 0; m < 4; ++m) { const int row = row0 + ai * HALF + m * 16;
                const float sa_ = sav[ai][m]; unsigned char* rowp = O + (size_t)row * ldc + col0;
                f32x4 v[2];
#pragma unroll
                for (int n = 0; n < 2; ++n)
#pragma unroll
                    for (int e = 0; e < 4; ++e) { const float gs = (float)acc[ai][0][m][n][e] * sa_; const float uf = (float)acc[ai][1][m][n][e];
                        const float r = __builtin_amdgcn_rcpf(1.0f + __builtin_amdgcn_exp2f(gs * cg[n][e]));
                        v[n][e] = (gs * uf) * (cw[n][e] * sa_) * r; }
                u32x2 w; w.x = pk4_fp8(v[0][0], v[0][1], v[0][2], v[0][3]); w.y = pk4_fp8(v[1][0], v[1][1], v[1][2], v[1][3]);
                *(u32x2*)rowp = w; }
    }
    __device__ __forceinline__ void operator()(const f32x4 (&acc)[2][2][4][2], const Unit& u, int wr, int wc, int fr, int fq) const {
        const int row0 = u.pm * BM + wr * 64 + fr, col0 = u.pn * HALF + wc * 32 + 8 * fq;
#pragma unroll
        for (int ai = 0; ai < 2; ++ai)
#pragma unroll
            for (int m = 0; m < 4; ++m) { unsigned char* rowp = O + (size_t)(row0 + ai * HALF + m * 16) * ldc + col0;
                f32x4 v0, v1;
#pragma unroll
                for (int e = 0; e < 4; ++e) { v0[e] = silu_f(acc[ai][0][m][0][e]) * acc[ai][1][m][0][e] * ACT_F8; v1[e] = silu_f(acc[ai][0][m][1][e]) * acc[ai][1][m][1][e] * ACT_F8; }
                u32x2 w; w.x = pk4_fp8(v0[0], v0[1], v0[2], v0[3]); w.y = pk4_fp8(v1[0], v1[1], v1[2], v1[3]);
                *(u32x2*)rowp = w; }
    }
};
struct EpiRetIn {
    static constexpr bool PERM = true; static constexpr bool RAW = false; static constexpr int NSTORE = 16;
    bf16_t *Q, *Kb, *V, *Gs; const int* pos; const float* sa; const float* sw;
    __device__ __forceinline__ void operator()(const f32x4 (&acc)[2][2][4][2], const Unit& u, int wr, int wc, int fr, int fq) const {
        const int row0 = u.pm * BM + wr * 64 + fr; const int pn = u.pn;
        if (pn < 8) {
            bf16_t* base = (pn < 4 ? Q : Kb) + (pn & 3) * RDK + wc * 32 + 8 * fq;
            const float lg2 = __builtin_amdgcn_logf(1.0f - __builtin_amdgcn_exp2f(-5.0f - (float)(pn & 3))) * (pn < 4 ? 1.0f : -1.0f); const float sc0 = pn < 4 ? 1.0f : 0.0625f;
            float invf[2][4];
#pragma unroll
            for (int n = 0; n < 2; ++n)
#pragma unroll
                for (int e = 0; e < 4; ++e) invf[n][e] = __builtin_amdgcn_exp2f(-(float)(32 * wc + 8 * fq + 4 * n + e) * 0.10381025296f) * 0.15915494309f;
            int posv[2][4];
#pragma unroll
            for (int ai = 0; ai < 2; ++ai)
#pragma unroll
                for (int m = 0; m < 4; ++m) posv[ai][m] = pos[row0 + ai * HALF + m * 16];
#pragma unroll
            for (int ai = 0; ai < 2; ++ai)
#pragma unroll
                for (int m = 0; m < 4; ++m) { const int row = row0 + ai * HALF + m * 16; const float p = (float)posv[ai][m]; bf16_t* rowp = base + (size_t)row * D; const float scale = sc0 * __builtin_amdgcn_exp2f((float)(row & 127) * lg2);
                    float o1[2][4], o2[2][4];
#pragma unroll
                    for (int n = 0; n < 2; ++n)
#pragma unroll
                        for (int e = 0; e < 4; ++e) { float r = p * invf[n][e]; r = __builtin_amdgcn_fractf(r); const float sn = __builtin_amdgcn_sinf(r), cs = __builtin_amdgcn_cosf(r);
                            const float t1 = acc[ai][0][m][n][e], t2 = acc[ai][1][m][n][e]; o1[n][e] = (t1 * cs - t2 * sn) * scale; o2[n][e] = (t2 * cs + t1 * sn) * scale; }
                    u32x4 w1, w2; w1.x = cvt_pk_bf16(o1[0][0], o1[0][1]); w1.y = cvt_pk_bf16(o1[0][2], o1[0][3]); w1.z = cvt_pk_bf16(o1[1][0], o1[1][1]); w1.w = cvt_pk_bf16(o1[1][2], o1[1][3]);
                    w2.x = cvt_pk_bf16(o2[0][0], o2[0][1]); w2.y = cvt_pk_bf16(o2[0][2], o2[0][3]); w2.z = cvt_pk_bf16(o2[1][0], o2[1][1]); w2.w = cvt_pk_bf16(o2[1][2], o2[1][3]);
                    *(u32x4*)rowp = w1; *(u32x4*)(rowp + HALF) = w2; }
        } else {
            const bool isG = pn >= 16; bf16_t* base = (isG ? Gs : V) + ((pn - 8) & 7) * BM + wc * 32 + 8 * fq;
#pragma unroll
            for (int ai = 0; ai < 2; ++ai)
#pragma unroll
                for (int m = 0; m < 4; ++m) { bf16_t* rowp = base + (size_t)(row0 + ai * HALF + m * 16) * (RH * RDV);
#pragma unroll
                    for (int bj = 0; bj < 2; ++bj) { f32x4 v0 = acc[ai][bj][m][0], v1 = acc[ai][bj][m][1];
                        u32x4 w; w.x = cvt_pk_bf16(v0[0], v0[1]); w.y = cvt_pk_bf16(v0[2], v0[3]); w.z = cvt_pk_bf16(v1[0], v1[1]); w.w = cvt_pk_bf16(v1[2], v1[3]);
                        *(u32x4*)(rowp + bj * HALF) = w; } }
        }
    }
};
struct EpiMoeDown {
    static constexpr bool PERM = true; static constexpr bool RAW = false; static constexpr int NSTORE = 0;
    bf16_t* P0; long long dP;     const int* idx; const float* gw; const float* sw; float f8s;
    __device__ __forceinline__ void operator()(const f32x4 (&acc)[2][2][4][2], const Unit& u, int wr, int wc, int fr, int fq) const {
        const int row0 = u.pm * BM + wr * 64 + fr, col0 = u.pn * BM + wc * 32 + 8 * fq;
        int vv[2][4]; float ww[2][4];
#pragma unroll
        for (int ai = 0; ai < 2; ++ai)
#pragma unroll
            for (int m = 0; m < 4; ++m) { const int r = row0 + ai * HALF + m * 16; vv[ai][m] = idx[r]; ww[ai][m] = gw[r]; }
        f32x4 sc[2][2];
#pragma unroll
        for (int bj = 0; bj < 2; ++bj) { const float* sp = sw + (size_t)u.pb * BM + wc * 32 + 8 * fq + bj * HALF; sc[bj][0] = *(const f32x4*)sp * f8s; sc[bj][1] = *(const f32x4*)(sp + 4) * f8s; }
#pragma unroll
        for (int ai = 0; ai < 2; ++ai)
#pragma unroll
            for (int m = 0; m < 4; ++m) { const int v = vv[ai][m];
                if (v >= 0) { const int tok = v >> 1; const float w = ww[ai][m]; bf16_t* xp = P0 + (long long)(v & 1) * dP + (size_t)tok * D + col0;
#pragma unroll
                    for (int bj = 0; bj < 2; ++bj) { const f32x4 a0 = acc[ai][bj][m][0] * sc[bj][0] * w, a1 = acc[ai][bj][m][1] * sc[bj][1] * w;
                        u32x4 o; o.x = cvt_pk_bf16(a0[0], a0[1]); o.y = cvt_pk_bf16(a0[2], a0[3]); o.z = cvt_pk_bf16(a1[0], a1[1]); o.w = cvt_pk_bf16(a1[2], a1[3]); *(u32x4*)(xp + bj * HALF) = o; } } }
    }
};
}

constexpr size_t MiB = 1u << 20;
constexpr size_t WS_CTL = 0, CTL_ZERO_BYTES = 1 * MiB;
constexpr size_t WS_MOD = 1 * MiB;
constexpr size_t WS_VSTAT = 2 * MiB;
constexpr size_t WS_RSTAT = 10 * MiB;
constexpr size_t WS_X16 = 16 * MiB;
constexpr size_t WS_W_SGU_IN = 80 * MiB, WS_W_SGU_OUT = 84 * MiB, WS_W_FFN_GU = 88 * MiB, WS_W_FFN_DN = 94 * MiB, WS_W_RET_IN = 100 * MiB, WS_W_RET_OUT = 106 * MiB;
constexpr size_t WS_W_MOE_GU = 110 * MiB, WS_W_MOE_DN = 154 * MiB;
constexpr size_t WS_XN = 198 * MiB;
constexpr size_t WS_P0 = WS_XN;
constexpr size_t WS_R1 = 262 * MiB;
constexpr size_t WS_U = WS_R1, WS_V = WS_R1 + 128 * MiB;
constexpr size_t WS_DELTA = WS_R1 + 256 * MiB;
constexpr size_t WS_ACT = WS_R1;
constexpr size_t WS_Q = WS_R1, WS_K = WS_R1 + 64 * MiB, WS_RV = WS_R1 + 128 * MiB, WS_G = WS_R1 + 256 * MiB;
constexpr size_t WS_P1 = WS_R1 + 363 * MiB;
constexpr size_t WS_SMALL = WS_P1 + 64 * MiB;
constexpr size_t WS_ROUTE = WS_SMALL;
constexpr size_t WS_RTAB = WS_SMALL + 768 * 1024;
constexpr size_t WS_LIST = WS_SMALL + 1 * MiB;
constexpr size_t WS_SA = WS_SMALL + 2 * MiB;
constexpr size_t WS_SW = WS_SMALL + 3 * MiB;
constexpr int SW_SGU = 0, SW_FFN = 2 * SGW, SW_RET = SW_FFN + 2 * FF, SW_MOE = SW_RET + RET_IN, SW_RO = SW_MOE + NE * 2 * FF, SW_MD = SW_RO + D, SW_FD = SW_MD + NE * D, NSW = SW_FD + D;
constexpr size_t CTL_COLMAX = 512 * 1024;
constexpr size_t LIST_IDX = 0, LIST_GW = (size_t)LCAP * 4, LIST_TE = LIST_GW + (size_t)LCAP * 4, LIST_NT = LIST_TE + (size_t)LTILES * 4, LIST_SAL = LIST_NT + 64;
constexpr size_t WS_END = WS_SMALL + 4 * MiB;
static_assert(WS_W_FFN_DN + (size_t)D * FF * 2 <= WS_W_RET_IN && WS_W_FFN_GU + (size_t)2 * FF * D <= WS_W_FFN_DN && WS_W_RET_IN + (size_t)RET_IN * D <= WS_W_RET_OUT && WS_W_MOE_GU + (size_t)NE * 2 * FF * D <= WS_W_MOE_DN && WS_W_MOE_DN + (size_t)NE * FF * D * 2 <= WS_XN, "weight map");
static_assert(WS_LIST + LIST_SAL + (size_t)LCAP * 4 <= WS_SA && WS_SW + (size_t)NSW * 4 <= WS_END && (size_t)LCAP * FF * 2 <= 363 * MiB && WS_X16 + (size_t)M * D * 2 <= WS_W_SGU_IN && WS_END <= 700 * MiB, "map");
constexpr int CW_BAR = 4096;

constexpr int RING_BYTES = 131072, LDSCTL_OFF = RING_BYTES, MISC_OFF = LDSCTL_OFF + 320, EXTRA_OFF = RING_BYTES + 1024, LDS_BYTES = 147456;

typedef float f32x4 __attribute__((ext_vector_type(4)));
typedef unsigned v4u __attribute__((ext_vector_type(4)));
typedef unsigned v2u __attribute__((ext_vector_type(2)));
#define LDS_WAIT() asm volatile("s_waitcnt lgkmcnt(0)" ::: "memory")
__device__ __forceinline__ unsigned f2bf(float f) { unsigned u = __builtin_bit_cast(unsigned, f); return (u + 0x7fffu + ((u >> 16) & 1u)) >> 16; }
__device__ __forceinline__ unsigned pk2(float lo, float hi) { return f2bf(lo) | (f2bf(hi) << 16); }
__device__ __forceinline__ float u2f(unsigned w) { return __builtin_bit_cast(float, w); }
__device__ __forceinline__ float bflo(unsigned w) { return __builtin_bit_cast(float, w << 16); }
__device__ __forceinline__ float bfhi(unsigned w) { return __builtin_bit_cast(float, w & 0xffff0000u); }
__device__ __forceinline__ float bf2f(bf16 b) { return __builtin_bit_cast(float, (unsigned)b << 16); }
template <int CTRL> __device__ __forceinline__ float dpp_f(float v) { return __builtin_bit_cast(float, __builtin_amdgcn_update_dpp(0, __builtin_bit_cast(int, v), CTRL, 0xf, 0xf, true)); }
__device__ __forceinline__ float rdl_f(float v, int l) { return __builtin_bit_cast(float, __builtin_amdgcn_readlane(__builtin_bit_cast(int, v), l)); }
__device__ __forceinline__ float wave_sum(float v, int lane) {
    (void)lane;
    v += dpp_f<0xB1>(v); v += dpp_f<0x4E>(v); v += dpp_f<0x141>(v); v += dpp_f<0x140>(v);
    return (rdl_f(v, 0) + rdl_f(v, 16)) + (rdl_f(v, 32) + rdl_f(v, 48));
}

#define XB_TMO      128
#define XB_XCNT(j)  (256  + 64 * (j))
#define XB_XSUB(j)  (1280 + 64 * (j))
#define XB_XGEN(j)  (2304 + 64 * (j))
#define XB_TOP      3328
#define XB_TOPGEN   3392
#define XCD_BAR_WORDS 3456
#define XB_SPIN_CAP (1u << 18)
__device__ __forceinline__ unsigned xb_ld(unsigned* p)              { return __hip_atomic_load(p, __ATOMIC_RELAXED, __HIP_MEMORY_SCOPE_AGENT); }
__device__ __forceinline__ unsigned xb_add(unsigned* p, unsigned v) { return __hip_atomic_fetch_add(p, v, __ATOMIC_RELAXED, __HIP_MEMORY_SCOPE_AGENT); }
__device__ __forceinline__ unsigned xb_xcc_id() { return (unsigned)__builtin_amdgcn_s_getreg((3 << 11) | 20) & 0xFu; }
#define XB_SPIN(cond, bar) do { unsigned _sp = 0; while (cond) { __builtin_amdgcn_s_sleep(1); \
    if ((++_sp & 255u) == 0u) { if (xb_ld(&(bar)[XB_TMO])) break; if (_sp > XB_SPIN_CAP) { atomicAdd(&(bar)[XB_TMO], 1u); break; } } } } while (0)
struct XcdBarrier { unsigned* bar; unsigned x; volatile LAS unsigned* st; };
__device__ __forceinline__ XcdBarrier xcd_barrier_post(unsigned* bar, volatile LAS unsigned* st) {
    XcdBarrier b; b.bar = bar; b.x = xb_xcc_id(); b.st = st;
    if (threadIdx.x == 0) st[2] = xb_add(&bar[XB_XCNT(b.x)], 1u);
    return b;
}
__device__ __forceinline__ void xcd_barrier_complete(unsigned* bar, unsigned x, unsigned& nloc, unsigned& nx) {
    const unsigned G = gridDim.x * gridDim.y * gridDim.z;
    unsigned sum, cnt, mine, sp = 0u;
    for (;;) {
        sum = 0u; cnt = 0u; mine = 0u;
#pragma unroll
        for (unsigned j = 0; j < 16; ++j) { const unsigned c = xb_ld(&bar[XB_XCNT(j)]); sum += c; cnt += (c > 0u) ? 1u : 0u; mine = (j == x) ? c : mine; }
        if (sum == G) break;
        __builtin_amdgcn_s_sleep(1);
        if ((++sp & 255u) == 0u) { if (xb_ld(&bar[XB_TMO])) break; if (sp > XB_SPIN_CAP) { atomicAdd(&bar[XB_TMO], 1u); break; } }
    }
    nloc = mine > 0u ? mine : 1u; nx = cnt > 0u ? cnt : 1u;
}
__device__ __forceinline__ void xcd_barrier(const XcdBarrier& b) {
    asm volatile("s_waitcnt vmcnt(0)" ::: "memory");
    __syncthreads();
    if (threadIdx.x == 0) {
        unsigned* bar = b.bar;
        __builtin_amdgcn_s_waitcnt(0);
        unsigned nloc = b.st[0], nx = b.st[1];
        if (nloc == 0u) { xcd_barrier_complete(bar, b.x, nloc, nx); b.st[0] = nloc; b.st[1] = nx; }
        const unsigned old = xb_add(&bar[XB_XSUB(b.x)], 1u);
        const unsigned gen = old / nloc;
        if (old + 1u == (gen + 1u) * nloc) {
            __builtin_amdgcn_fence(__ATOMIC_RELEASE, "agent");
            asm volatile("s_waitcnt vmcnt(0)" ::: "memory");
            const unsigned og = xb_add(&bar[XB_TOP], 1u);
            const unsigned tg = og / nx;
            if (og + 1u == (tg + 1u) * nx) xb_add(&bar[XB_TOPGEN], 1u);
            else XB_SPIN(xb_ld(&bar[XB_TOPGEN]) == tg, bar);
            __builtin_amdgcn_fence(__ATOMIC_ACQUIRE, "agent");
            xb_add(&bar[XB_XGEN(b.x)], 1u);
            asm volatile("s_waitcnt vmcnt(0)" ::: "memory");
        } else {
            XB_SPIN(xb_ld(&bar[XB_XGEN(b.x)]) == gen, bar);
            __builtin_amdgcn_fence(__ATOMIC_ACQUIRE, "agent");
            asm volatile("s_waitcnt vmcnt(0)" ::: "memory");
        }
    }
    __syncthreads();
}

__device__ __forceinline__ void mod_phase(const float* c, const float* ada_w, const float* ada_b, float* MOD, LAS unsigned char* lds, int tid, int lane, int wave, int bid, int G) {
    LAS float* sc = (LAS float*)lds;
    LAS float* red = (LAS float*)(lds + 32768);
    for (int i = tid; i < NB * D; i += 512) { const float v = c[i]; sc[i] = v / (1.0f + __expf(-v)); }
    __syncthreads();
    constexpr int CPI = 48, NITEM = 2 * MODW / CPI;
    for (int it = bid; it < NITEM; it += G) {
        const int col = it * CPI + (lane < CPI ? lane : CPI - 1); const int l = col / MODW, cl = col % MODW;
        const float* w = ada_w + (size_t)l * D * MODW + (size_t)(wave * 128) * MODW + cl;
        float a[NB];
#pragma unroll
        for (int b = 0; b < NB; ++b) a[b] = 0.f;
#pragma unroll 8
        for (int k = 0; k < 128; ++k) { const float wv = w[(size_t)k * MODW];
#pragma unroll
            for (int b = 0; b < NB; ++b) a[b] += sc[b * D + wave * 128 + k] * wv; }
#pragma unroll
        for (int b = 0; b < NB; ++b) red[(wave * NB + b) * 64 + lane] = a[b];
        __syncthreads();
        { const int b = tid >> 6; float s = 0.f;
#pragma unroll
            for (int w8 = 0; w8 < 8; ++w8) s += red[(w8 * NB + b) * 64 + lane];
            if (lane < CPI) MOD[(size_t)(l * NB + b) * MODW + cl] = s + ada_b[l * MODW + cl]; }
        __syncthreads();
    }
}
template <int MODE>
__device__ __forceinline__ void cvt_item(const float* W, int K, int N, bf16* WT, LAS float* scr, int item, int lane) {
    const int nblk = N / 32, kb = item / nblk, nb = item % nblk, k0 = 64 * kb, n0 = 32 * nb;
    int drow0 = n0;
    if (MODE == 1) { const int half = n0 >= FF ? 1 : 0; const int j = n0 - half * FF; drow0 = (j >> 7) * 256 + half * 128 + (j & 127); }
#pragma unroll 8
    for (int i = 0; i < 32; ++i) { const int kk = 2 * i + (lane >> 5); scr[kk * 33 + (lane & 31)] = W[(size_t)(k0 + kk) * N + n0 + (lane & 31)]; }
    LDS_WAIT(); asm volatile("" ::: "memory");
    const int c = lane & 7;
#pragma unroll
    for (int j = 0; j < 4; ++j) { const int n = (lane >> 3) + 8 * j; const LAS float* s = scr + (8 * c) * 33 + n;
        v4u o; o.x = pk2(s[0 * 33], s[1 * 33]); o.y = pk2(s[2 * 33], s[3 * 33]); o.z = pk2(s[4 * 33], s[5 * 33]); o.w = pk2(s[6 * 33], s[7 * 33]);
        *(v4u*)(WT + (size_t)(drow0 + n) * K + k0 + 8 * c) = o; }
    LDS_WAIT(); asm volatile("" ::: "memory");
}
constexpr int AMK = 32;
template <int MODE>
__device__ __forceinline__ void amax_item(const float* W, int K, int N, unsigned* cmax, int item, int lane) {
    const int nblk = N / 256, kb = item / nblk, nb = item % nblk, k0 = AMK * kb, n0 = 256 * nb + 4 * lane;
    int drow0 = n0;
    if (MODE == 1) { const int half = n0 >= FF ? 1 : 0; const int j = n0 - half * FF; drow0 = (j >> 7) * 256 + half * 128 + (j & 127); }
    f32x4 mx = {0.f, 0.f, 0.f, 0.f};
    const float* wp = W + (size_t)k0 * N + n0;
#pragma unroll 8
    for (int i = 0; i < AMK; ++i) { const f32x4 v = *(const f32x4*)(wp + (size_t)i * N); mx[0] = fmaxf(mx[0], fabsf(v[0])); mx[1] = fmaxf(mx[1], fabsf(v[1])); mx[2] = fmaxf(mx[2], fabsf(v[2])); mx[3] = fmaxf(mx[3], fabsf(v[3])); }
#pragma unroll
    for (int e = 0; e < 4; ++e) atomicMax(cmax + drow0 + e, __builtin_bit_cast(unsigned, (float)mx[e]));
}
template <int MODE>
__device__ __forceinline__ void cvt8_item(const float* W, int K, int N, signed char* WT, const unsigned* cmax, float* sw, LAS float* scr, int item, int lane) {
    const int nblk = N / 32, kb = item / nblk, nb = item % nblk, k0 = 64 * kb, n0 = 32 * nb;
    int drow0 = n0;
    if (MODE == 1) { const int half = n0 >= FF ? 1 : 0; const int j = n0 - half * FF; drow0 = (j >> 7) * 256 + half * 128 + (j & 127); }
#pragma unroll 8
    for (int i = 0; i < 32; ++i) { const int kk = 2 * i + (lane >> 5); scr[kk * 33 + (lane & 31)] = W[(size_t)(k0 + kk) * N + n0 + (lane & 31)]; }
    LDS_WAIT(); asm volatile("" ::: "memory");
    const int c = lane & 7;
#pragma unroll
    for (int j = 0; j < 4; ++j) { const int n = (lane >> 3) + 8 * j; const LAS float* sp = scr + (8 * c) * 33 + n;
        const float am = u2f(cmax[drow0 + n]); const float inv = am > 0.f ? 127.0f / am : 0.f;
        unsigned w0 = 0u, w1 = 0u;
#pragma unroll
        for (int e = 0; e < 4; ++e) { const int q0 = (int)__builtin_rintf(sp[e * 33] * inv), q1 = (int)__builtin_rintf(sp[(4 + e) * 33] * inv); w0 |= ((unsigned)q0 & 0xffu) << (8 * e); w1 |= ((unsigned)q1 & 0xffu) << (8 * e); }
        v2u o; o.x = w0; o.y = w1; *(v2u*)(WT + (size_t)(drow0 + n) * K + k0 + 8 * c) = o;
        if (kb == 0 && c == 0) sw[drow0 + n] = am * (1.0f / 127.0f); }
    LDS_WAIT(); asm volatile("" ::: "memory");
}
__device__ __forceinline__ void cvtf8_item(const float* W, int K, int N, unsigned char* WT, const unsigned* cmax, float* sw, LAS float* scr, int item, int lane) {
    const int nblk = N / 32, kb = item / nblk, nb = item % nblk, k0 = 64 * kb, n0 = 32 * nb;
#pragma unroll 8
    for (int i = 0; i < 32; ++i) { const int kk = 2 * i + (lane >> 5); scr[kk * 33 + (lane & 31)] = W[(size_t)(k0 + kk) * N + n0 + (lane & 31)]; }
    LDS_WAIT(); asm volatile("" ::: "memory");
    const int c = lane & 7;
#pragma unroll
    for (int j = 0; j < 4; ++j) { const int n = (lane >> 3) + 8 * j; const LAS float* sp = scr + (8 * c) * 33 + n;
        const float am = u2f(cmax[n0 + n]); int ex = 0; if (am > 0.f) ex = 7 - ((int)((cmax[n0 + n] >> 23) & 0xffu) - 127);
        ex -= 1; const float sc = __builtin_ldexpf(1.0f, ex);
        v2u o; o.x = pg8::pk4_fp8(sp[0 * 33] * sc, sp[1 * 33] * sc, sp[2 * 33] * sc, sp[3 * 33] * sc); o.y = pg8::pk4_fp8(sp[4 * 33] * sc, sp[5 * 33] * sc, sp[6 * 33] * sc, sp[7 * 33] * sc);
        *(v2u*)(WT + (size_t)(n0 + n) * K + k0 + 8 * c) = o;
        if (kb == 0 && c == 0) sw[n0 + n] = __builtin_ldexpf(1.0f, -ex); }
    LDS_WAIT(); asm volatile("" ::: "memory");
}
template <int MODE, bool F8>
__device__ __forceinline__ void cvtq_tile(const float* W, int K, int N, unsigned char* WT, const unsigned* cmax, float* sw, LAS float* scr, int item, int tid) {
    const int nblk = N / 128, kb = item / nblk, nb = item % nblk, k0 = 128 * kb, n0 = 128 * nb;
    int drow0 = n0;
    if (MODE == 1) { const int half = n0 >= FF ? 1 : 0; const int j = n0 - half * FF; drow0 = (j >> 7) * 256 + half * 128; }
    const int lane = tid & 63, w = tid >> 6;
    { const float* wp = W + (size_t)(k0 + w * 16 + (lane >> 5)) * N + n0 + (lane & 31) * 4;
      f32x4 v[8];
#pragma unroll
      for (int i = 0; i < 8; ++i) v[i] = *(const f32x4*)(wp + (size_t)(2 * i) * N);
#pragma unroll
      for (int i = 0; i < 8; ++i) *(LAS f32x4*)(scr + (w * 16 + 2 * i + (lane >> 5)) * 132 + (lane & 31) * 4) = v[i]; }
    __syncthreads();
    { const int n = tid & 127, kq = tid >> 7;
      const unsigned cm = cmax[drow0 + n]; const float am = u2f(cm);
      float sc, swv;
      if (F8) { int ex = 0; if (am > 0.f) ex = 7 - ((int)((cm >> 23) & 0xffu) - 127); ex -= 1; sc = __builtin_ldexpf(1.0f, ex); swv = __builtin_ldexpf(1.0f, -ex); }
      else { sc = am > 0.f ? 127.0f / am : 0.f; swv = am * (1.0f / 127.0f); }
      const LAS float* sp = scr + (32 * kq) * 132 + n;
      unsigned o[8];
#pragma unroll
      for (int q = 0; q < 8; ++q) { const float a = sp[(4 * q + 0) * 132] * sc, b = sp[(4 * q + 1) * 132] * sc, c = sp[(4 * q + 2) * 132] * sc, d = sp[(4 * q + 3) * 132] * sc;
          if (F8) o[q] = pg8::pk4_fp8(a, b, c, d);
          else o[q] = ((unsigned)(int)__builtin_rintf(a) & 0xffu) | (((unsigned)(int)__builtin_rintf(b) & 0xffu) << 8) | (((unsigned)(int)__builtin_rintf(c) & 0xffu) << 16) | (((unsigned)(int)__builtin_rintf(d) & 0xffu) << 24); }
      v4u* dst = (v4u*)(WT + (size_t)(drow0 + n) * K + k0 + 32 * kq);
      v4u o0, o1; o0.x = o[0]; o0.y = o[1]; o0.z = o[2]; o0.w = o[3]; o1.x = o[4]; o1.y = o[5]; o1.z = o[6]; o1.w = o[7];
      dst[0] = o0; dst[1] = o1;
      if (kb == 0 && kq == 0) sw[drow0 + n] = swv; }
    __syncthreads();
}
struct WPtrs { const float *sgu_in, *sgu_out, *ffn_gu, *ffn_dn, *ret_in, *ret_out, *moe_gu, *moe_dn; };
constexpr int CI0 = (D / 64) * (2 * SGW / 32), CI1 = (SGW / 64) * (D / 32), CI2 = (D / 64) * (2 * FF / 32), CI3 = (FF / 64) * (D / 32), CI4 = (D / 64) * (RET_IN / 32), CI5 = (RH * RDV / 64) * (D / 32);
__device__ __forceinline__ void cvt_phase_a(const WPtrs& P, unsigned char* ws, LAS unsigned char* lds, int gw, int NGW, int wave, int lane) {
    LAS float* scr = (LAS float*)(lds + wave * 16384);
    unsigned* cmax = (unsigned*)(ws + WS_CTL + CTL_COLMAX);
    constexpr int AI0 = (D / AMK) * (2 * SGW / 256), AI2 = (D / AMK) * (2 * FF / 256), AI3 = (FF / AMK) * (D / 256), AI4 = (D / AMK) * (RET_IN / 256), AI5 = (RH * RDV / AMK) * (D / 256);
    static_assert(D % AMK == 0 && FF % AMK == 0 && (RH * RDV) % AMK == 0 && FF % 256 == 0 && (2 * SGW) % 256 == 0 && RET_IN % 256 == 0, "absmax item shape");
    constexpr int NIT = CI1 + AI3 + AI5 + NE * AI3 + AI0 + AI2 + AI4 + NE * AI2;
    for (int it = gw; it < NIT; it += NGW) {
        int r = it;
        if (r < CI1) { cvt_item<0>(P.sgu_out, SGW, D, (bf16*)(ws + WS_W_SGU_OUT), scr, r, lane); continue; } r -= CI1;
        if (r < AI3) { amax_item<0>(P.ffn_dn, FF, D, cmax + SW_FD, r, lane); continue; } r -= AI3;
        if (r < AI5) { amax_item<0>(P.ret_out, RH * RDV, D, cmax + SW_RO, r, lane); continue; } r -= AI5;
        if (r < NE * AI3) { const int e = r / AI3; amax_item<0>(P.moe_dn + (size_t)e * FF * D, FF, D, cmax + SW_MD + e * D, r % AI3, lane); continue; } r -= NE * AI3;
        if (r < AI0) { amax_item<0>(P.sgu_in, D, 2 * SGW, cmax + SW_SGU, r, lane); continue; } r -= AI0;
        if (r < AI2) { amax_item<1>(P.ffn_gu, D, 2 * FF, cmax + SW_FFN, r, lane); continue; } r -= AI2;
        if (r < AI4) { amax_item<0>(P.ret_in, D, RET_IN, cmax + SW_RET, r, lane); continue; } r -= AI4;
        { const int e = r / AI2; amax_item<1>(P.moe_gu + (size_t)e * D * 2 * FF, D, 2 * FF, cmax + SW_MOE + e * 2 * FF, r % AI2, lane); }
    }
}
__device__ __forceinline__ void cvt_phase_b(const WPtrs& P, unsigned char* ws, LAS unsigned char* lds, int bid, int G, int tid) {
    LAS float* scr = (LAS float*)lds;
    const unsigned* cmax = (const unsigned*)(ws + WS_CTL + CTL_COLMAX); float* sw = (float*)(ws + WS_SW);
    constexpr int T0 = (D / 128) * (2 * SGW / 128), T2 = (D / 128) * (2 * FF / 128), T3 = (FF / 128) * (D / 128), T4 = (D / 128) * (RET_IN / 128), T5 = (RH * RDV / 128) * (D / 128);
    static_assert(FF % 128 == 0 && D % 128 == 0 && RET_IN % 128 == 0 && (2 * SGW) % 128 == 0 && (RH * RDV) % 128 == 0, "pass-B tile shape");
    constexpr int NIT = T3 + NE * T3 + T5 + T0 + T2 + T4 + NE * T2;
    for (int it = bid; it < NIT; it += G) {
        int r = it;
        if (r < T3) { cvtq_tile<0, true>(P.ffn_dn, FF, D, (unsigned char*)(ws + WS_W_FFN_DN), cmax + SW_FD, sw + SW_FD, scr, r, tid); continue; } r -= T3;
        if (r < NE * T3) { const int e = r / T3; cvtq_tile<0, true>(P.moe_dn + (size_t)e * FF * D, FF, D, (unsigned char*)(ws + WS_W_MOE_DN) + (size_t)e * D * FF, cmax + SW_MD + e * D, sw + SW_MD + e * D, scr, r % T3, tid); continue; } r -= NE * T3;
        if (r < T5) { cvtq_tile<0, false>(P.ret_out, RH * RDV, D, (unsigned char*)(ws + WS_W_RET_OUT), cmax + SW_RO, sw + SW_RO, scr, r, tid); continue; } r -= T5;
        if (r < T0) { cvtq_tile<0, false>(P.sgu_in, D, 2 * SGW, (unsigned char*)(ws + WS_W_SGU_IN), cmax + SW_SGU, sw + SW_SGU, scr, r, tid); continue; } r -= T0;
        if (r < T2) { cvtq_tile<1, false>(P.ffn_gu, D, 2 * FF, (unsigned char*)(ws + WS_W_FFN_GU), cmax + SW_FFN, sw + SW_FFN, scr, r, tid); continue; } r -= T2;
        if (r < T4) { cvtq_tile<0, false>(P.ret_in, D, RET_IN, (unsigned char*)(ws + WS_W_RET_IN), cmax + SW_RET, sw + SW_RET, scr, r, tid); continue; } r -= T4;
        { const int e = r / T2; cvtq_tile<1, false>(P.moe_gu + (size_t)e * D * 2 * FF, D, 2 * FF, (unsigned char*)(ws + WS_W_MOE_GU) + (size_t)e * 2 * FF * D, cmax + SW_MOE + e * 2 * FF, sw + SW_MOE + e * 2 * FF, scr, r % T2, tid); }
    }
}
__device__ __forceinline__ float wave_max(float v, int lane) {
    (void)lane;
    v = fmaxf(v, dpp_f<0xB1>(v)); v = fmaxf(v, dpp_f<0x4E>(v)); v = fmaxf(v, dpp_f<0x141>(v)); v = fmaxf(v, dpp_f<0x140>(v));
    return fmaxf(fmaxf(rdl_f(v, 0), rdl_f(v, 16)), fmaxf(rdl_f(v, 32), rdl_f(v, 48)));
}
__device__ __forceinline__ float quant_row_store(const f32x4 (&o)[4], signed char* dst, int lane) {
    float am = 0.f;
#pragma unroll
    for (int j = 0; j < 4; ++j) am = fmaxf(fmaxf(am, fmaxf(fabsf(o[j].x), fabsf(o[j].y))), fmaxf(fabsf(o[j].z), fabsf(o[j].w)));
    am = wave_max(am, lane); const float inv = am > 0.f ? 127.0f / am : 0.f;
    unsigned* d4 = (unsigned*)dst + lane;
#pragma unroll
    for (int j = 0; j < 4; ++j) { const int q0 = (int)__builtin_rintf(o[j].x * inv), q1 = (int)__builtin_rintf(o[j].y * inv), q2 = (int)__builtin_rintf(o[j].z * inv), q3 = (int)__builtin_rintf(o[j].w * inv);
        d4[64 * j] = ((unsigned)q0 & 0xffu) | (((unsigned)q1 & 0xffu) << 8) | (((unsigned)q2 & 0xffu) << 16) | (((unsigned)q3 & 0xffu) << 24); }
    return am * (1.0f / 127.0f);
}
template <bool XBF>
__device__ __forceinline__ void norm_phase(const void* X, const bf16* delta, bf16* X16out, const float* g, const float* msh, const float* ms, signed char* XN, float* SA, int gw, int NGW, int lane) {
    const int wpb = NGW / NB, b = gw / wpb, r0 = gw - b * wpb;
    if (b >= NB) return;
    f32x4 ga[4], hv[4];
    { const f32x4* gp = (const f32x4*)g + lane; const f32x4* sp = (const f32x4*)(ms + (size_t)b * MODW) + lane; const f32x4* hp = (const f32x4*)(msh + (size_t)b * MODW) + lane;
#pragma unroll
      for (int j = 0; j < 4; ++j) { ga[j] = gp[64 * j] * (1.0f + sp[64 * j]); hv[j] = hp[64 * j]; } }
    for (int r = r0; r < SEQ; r += 2 * wpb) {
        int mm[2]; mm[0] = b * SEQ + r; mm[1] = b * SEQ + (r + wpb < SEQ ? r + wpb : r);
        f32x4 v[2][4]; v2u dd[2][4];
#pragma unroll
        for (int q = 0; q < 2; ++q)
#pragma unroll
            for (int j = 0; j < 4; ++j) {
                if (XBF) { const v2u xx = ((const v2u*)((const bf16*)X + (size_t)mm[q] * D) + lane)[64 * j]; v[q][j] = (f32x4){bflo(xx.x), bfhi(xx.x), bflo(xx.y), bfhi(xx.y)}; }
                else v[q][j] = ((const f32x4*)((const float*)X + (size_t)mm[q] * D) + lane)[64 * j];
                if (delta) dd[q][j] = ((const v2u*)(delta + (size_t)mm[q] * D) + lane)[64 * j]; }
#pragma unroll
        for (int q = 0; q < 2; ++q) { const int m = mm[q]; float ss = 0.f;
#pragma unroll
            for (int j = 0; j < 4; ++j) {
                if (delta) { const v2u d2 = dd[q][j]; v[q][j].x += bflo(d2.x); v[q][j].y += bfhi(d2.x); v[q][j].z += bflo(d2.y); v[q][j].w += bfhi(d2.y);
                    v2u w; w.x = pk2(v[q][j].x, v[q][j].y); w.y = pk2(v[q][j].z, v[q][j].w); ((v2u*)(X16out + (size_t)m * D) + lane)[64 * j] = w;
                    v[q][j] = (f32x4){bflo(w.x), bfhi(w.x), bflo(w.y), bfhi(w.y)}; }
                ss += (v[q][j].x * v[q][j].x + v[q][j].y * v[q][j].y) + (v[q][j].z * v[q][j].z + v[q][j].w * v[q][j].w); }
            const float rstd = 1.0f / sqrtf(wave_sum(ss, lane) * (1.0f / D) + EPS);
            f32x4 o[4];
#pragma unroll
            for (int j = 0; j < 4; ++j) o[j] = v[q][j] * rstd * ga[j] + hv[j];
            const float sc = quant_row_store(o, XN + (size_t)m * D, lane);
            if (lane == 0) SA[m] = sc; }
    }
}
typedef short s16x4 __attribute__((ext_vector_type(4)));
typedef short bfx8 __attribute__((ext_vector_type(8)));
__device__ __forceinline__ s16x4 ds_tr(LAS unsigned char* p) { return __builtin_amdgcn_ds_read_tr16_b64_v4i16((LAS s16x4*)p); }
__device__ __forceinline__ bfx8 cat8(s16x4 a, s16x4 b) { return __builtin_shufflevector(a, b, 0, 1, 2, 3, 4, 5, 6, 7); }
__device__ __forceinline__ bfx8 pack8(const f32x4& lo, const f32x4& hi) { v4u w; w.x = pg8::cvt_pk_bf16(lo[0], lo[1]); w.y = pg8::cvt_pk_bf16(lo[2], lo[3]); w.z = pg8::cvt_pk_bf16(hi[0], hi[1]); w.w = pg8::cvt_pk_bf16(hi[2], hi[3]); return __builtin_bit_cast(bfx8, w); }
#define MFMA16(a, b, c) __builtin_amdgcn_mfma_f32_16x16x32_bf16((a), (b), (c), 0, 0, 0)

constexpr int SG_WP = 272, SG_VP = 528, SG_W_OFF = 0, SG_V_OFF = 128 * SG_WP, SG_ST_OFF = SG_V_OFF + 128 * SG_VP;
__device__ __forceinline__ void sgate_mfma(bf16* U, const bf16* V, const float2* vstat, const float* lng, const float* lnb, const float* w_s, const float* b_s,
                                           LAS unsigned char* lds, int tid, int bid, int G) {
    const int lane = tid & 63, wave = __builtin_amdgcn_readfirstlane(tid >> 6), l15 = lane & 15, q = lane >> 4;
    LAS unsigned char* Wb = lds + SG_W_OFF; LAS unsigned char* vn = lds + SG_V_OFF; LAS float* st = (LAS float*)(lds + SG_ST_OFF);
    constexpr int NU = (M / CH) * NGRP;
    int gprev = -1;
    f32x4 g0 = {0.f, 0.f, 0.f, 0.f}, g1 = g0, b0 = g0, b1 = g0;
    v4u vraw[8]; f32x4 sraw[4];
#define SG_LOADV(uu_) { const int g_ = (uu_) & 7, n_ = (uu_) >> 3; \
        _Pragma("unroll") for (int i = 0; i < 8; ++i) vraw[i] = *(const v4u*)(V + (size_t)(n_ * CH + (tid >> 5) + 16 * i) * SGW + g_ * 256 + (tid & 31) * 8); \
        const f32x4* sp_ = (const f32x4*)(vstat + (size_t)(n_ * CH + (tid >> 2)) * 32 + (tid & 3) * 8); \
        _Pragma("unroll") for (int i = 0; i < 4; ++i) sraw[i] = sp_[i]; }
    if (bid < NU) SG_LOADV(bid)
    for (int unit = bid; unit < NU; unit += G) {
        const int g = unit & 7, n = unit >> 3;
        __syncthreads();
        if (g != gprev) { gprev = g;
            for (int i = tid; i < CH * CH / 4; i += 512) { const int t = i >> 5, s4 = (i & 31) * 4; f32x4 w = *(const f32x4*)(w_s + (size_t)g * CH * CH + t * CH + s4);
                if (s4 + 0 > t) w.x = 0.f; if (s4 + 1 > t) w.y = 0.f; if (s4 + 2 > t) w.z = 0.f; if (s4 + 3 > t) w.w = 0.f;
                v2u o; o.x = pk2(w.x, w.y); o.y = pk2(w.z, w.w); *(LAS v2u*)(Wb + t * SG_WP + s4 * 2) = o; }
            const int col = g * 256 + (tid & 31) * 8;
            g0 = *(const f32x4*)(lng + col); g1 = *(const f32x4*)(lng + col + 4); b0 = *(const f32x4*)(lnb + col); b1 = *(const f32x4*)(lnb + col + 4); }
        { float sx = (sraw[0].x + sraw[0].z) + (sraw[1].x + sraw[1].z) + (sraw[2].x + sraw[2].z) + (sraw[3].x + sraw[3].z);
          float sq = (sraw[0].y + sraw[0].w) + (sraw[1].y + sraw[1].w) + (sraw[2].y + sraw[2].w) + (sraw[3].y + sraw[3].w);
          sx += dpp_f<0xB1>(sx); sx += dpp_f<0x4E>(sx); sq += dpp_f<0xB1>(sq); sq += dpp_f<0x4E>(sq);
          const float mean = sx * (1.0f / SGW); const float var = sq * (1.0f / SGW) - mean * mean;
          if ((tid & 3) == 0) { st[2 * (tid >> 2)] = mean; st[2 * (tid >> 2) + 1] = 1.0f / sqrtf(var + EPS); } }
        __syncthreads();
#pragma unroll
        for (int i = 0; i < 8; ++i) { const int r = (tid >> 5) + 16 * i, c8 = (tid & 31) * 8;
            const v4u raw = vraw[i]; const float mean = st[2 * r], rstd = st[2 * r + 1];
            v4u o; o.x = pk2((bflo(raw.x) - mean) * rstd * g0.x + b0.x, (bfhi(raw.x) - mean) * rstd * g0.y + b0.y); o.y = pk2((bflo(raw.y) - mean) * rstd * g0.z + b0.z, (bfhi(raw.y) - mean) * rstd * g0.w + b0.w);
            o.z = pk2((bflo(raw.z) - mean) * rstd * g1.x + b1.x, (bfhi(raw.z) - mean) * rstd * g1.y + b1.y); o.w = pk2((bflo(raw.w) - mean) * rstd * g1.z + b1.z, (bfhi(raw.w) - mean) * rstd * g1.w + b1.w);
            *(LAS v4u*)(vn + r * SG_VP + c8 * 2) = o; }
        v2u uu[8][2];
#pragma unroll
        for (int T = 0; T < 8; ++T)
#pragma unroll
            for (int ct = 0; ct < 2; ++ct) uu[T][ct] = *(const v2u*)(U + (size_t)(n * CH + 16 * T + l15) * SGW + g * 256 + 32 * wave + 16 * ct + 4 * q);
        { const int nu = unit + G < NU ? unit + G : unit; SG_LOADV(nu) }
        __syncthreads();
        bfx8 af[4][2];
#pragma unroll
        for (int ks = 0; ks < 4; ++ks)
#pragma unroll
            for (int ct = 0; ct < 2; ++ct) { LAS unsigned char* p0 = vn + (32 * ks + 8 * q + (l15 >> 2)) * SG_VP + (32 * wave + 16 * ct + 4 * (l15 & 3)) * 2; af[ks][ct] = cat8(ds_tr(p0), ds_tr(p0 + 4 * SG_VP)); }
        f32x4 acc[2][8];
#pragma unroll
        for (int T = 0; T < 8; ++T) { acc[0][T] = (f32x4){0.f, 0.f, 0.f, 0.f}; acc[1][T] = (f32x4){0.f, 0.f, 0.f, 0.f};
#pragma unroll
            for (int ks = 0; ks <= T / 2; ++ks) { const bfx8 bfr = *(const LAS bfx8*)(Wb + (16 * T + l15) * SG_WP + (32 * ks + 8 * q) * 2);
                acc[0][T] = MFMA16(af[ks][0], bfr, acc[0][T]); acc[1][T] = MFMA16(af[ks][1], bfr, acc[1][T]); } }
#pragma unroll
        for (int T = 0; T < 8; ++T) { const int t = 16 * T + l15; const float bs = b_s[g * CH + t];
#pragma unroll
            for (int ct = 0; ct < 2; ++ct) { bf16* up = U + (size_t)(n * CH + t) * SGW + g * 256 + 32 * wave + 16 * ct + 4 * q; const v2u u2 = uu[T][ct]; const f32x4 a = acc[ct][T];
                v2u o; o.x = pk2(pg8::gelu_f(bflo(u2.x)) * (a[0] + bs), pg8::gelu_f(bfhi(u2.x)) * (a[1] + bs)); o.y = pk2(pg8::gelu_f(bflo(u2.y)) * (a[2] + bs), pg8::gelu_f(bfhi(u2.y)) * (a[3] + bs)); *(v2u*)up = o; } }
    }
#undef SG_LOADV
}

constexpr int RT_PK = 528, RT_PV = 144, RT_KS = 0, RT_VS = 128 * RT_PK, RT_SF = RT_VS + 128 * RT_PV;
static_assert(RT_SF + 32768 <= RING_BYTES, "retention LDS map");
__device__ __forceinline__ void ret_mfma(const bf16* Q, const bf16* Kb, bf16* VO, float* rstat, LAS unsigned char* lds, int tid, int bid, int G) {
    const int lane = tid & 63, wave = __builtin_amdgcn_readfirstlane(tid >> 6), l15 = lane & 15, q = lane >> 4;
    const int tt = wave < 4 ? wave : 11 - wave;
    LAS unsigned char* KS = lds + RT_KS; LAS unsigned char* VS = lds + RT_VS; LAS unsigned char* SF = lds + RT_SF;
    for (int u0 = bid; u0 < NB * RH * 8; u0 += G) {
        const int unit = (G == 256) ? ((u0 & 7) * 32 + (u0 >> 3)) : u0;
        const int b = unit >> 5, h = (unit >> 3) & 3, js = unit & 7;
        const float cd = __builtin_amdgcn_exp2f(128.0f * __builtin_amdgcn_logf(1.0f - __builtin_amdgcn_exp2f(-5.0f - (float)h)));
        f32x4 S[2][4];
#pragma unroll
        for (int ci = 0; ci < 2; ++ci)
#pragma unroll
            for (int vt = 0; vt < 4; ++vt) S[ci][vt] = (f32x4){0.f, 0.f, 0.f, 0.f};
        const char* kbase = (const char*)(Kb + (size_t)(b * SEQ) * D + h * RDK); const char* vbase = (const char*)(VO + (size_t)(b * SEQ) * (RH * RDV) + h * RDV + js * 64);
        const char* qbase = (const char*)(Q + (size_t)(b * SEQ) * D + h * RDK);
        const unsigned koff = (unsigned)((tid >> 5) * D + (tid & 31) * 8) * 2u, voff = (unsigned)((tid >> 3) * (RH * RDV) + (tid & 7) * 8) * 2u, qoff = (unsigned)((16 * tt + l15) * D + 8 * q) * 2u;
        __syncthreads();
#pragma unroll
        for (int i = 0; i < 4; ++i) *(LAS v4u*)(SF + (tid + 512 * i) * 16) = (v4u){0u, 0u, 0u, 0u};
        v4u kr[8], vr[2];
#pragma unroll
        for (int i = 0; i < 8; ++i) kr[i] = *(const v4u*)(kbase + (size_t)i * 16 * D * 2 + koff);
#pragma unroll
        for (int i = 0; i < 2; ++i) vr[i] = *(const v4u*)(vbase + (size_t)i * 64 * (RH * RDV) * 2 + voff);
#pragma unroll
        for (int i = 0; i < 8; ++i) { const int p = tid + 512 * i; *(LAS v4u*)(KS + (p >> 5) * RT_PK + (p & 31) * 16) = kr[i]; }
#pragma unroll
        for (int i = 0; i < 2; ++i) { const int p = tid + 512 * i; *(LAS v4u*)(VS + (p >> 3) * RT_PV + (p & 7) * 16) = vr[i]; }
        bfx8 qf[8];
#pragma unroll
        for (int ks = 0; ks < 8; ++ks) qf[ks] = *(const bfx8*)(qbase + 64 * ks + qoff);
        __syncthreads();
        for (int n = 0; n < SEQ / CH; ++n) {
            const int rowbase = b * SEQ + n * CH;
            const int nn = (n + 1 < SEQ / CH) ? n + 1 : n;
#pragma unroll
            for (int i = 0; i < 8; ++i) kr[i] = *(const v4u*)(kbase + (size_t)(nn * CH + i * 16) * D * 2 + koff);
#pragma unroll
            for (int i = 0; i < 2; ++i) vr[i] = *(const v4u*)(vbase + (size_t)(nn * CH + i * 64) * (RH * RDV) * 2 + voff);
            f32x4 pacc[8];
#pragma unroll
            for (int Si = 0; Si < 8; ++Si) { pacc[Si] = (f32x4){0.f, 0.f, 0.f, 0.f};
                if (Si <= tt) {
                    bfx8 ka[8];
#pragma unroll
                    for (int ks = 0; ks < 8; ++ks) ka[ks] = *(const LAS bfx8*)(KS + (16 * Si + l15) * RT_PK + (32 * ks + 8 * q) * 2);
                    __builtin_amdgcn_sched_barrier(0);
#pragma unroll
                    for (int ks = 0; ks < 8; ++ks) pacc[Si] = MFMA16(ka[ks], qf[ks], pacc[Si]);
                    if (Si == tt) {
#pragma unroll
                        for (int e = 0; e < 4; ++e) if (4 * q + e > l15) pacc[Si][e] = 0.f; } } }
            f32x4 oacc[4];
#pragma unroll
            for (int vt = 0; vt < 4; ++vt) oacc[vt] = (f32x4){0.f, 0.f, 0.f, 0.f};
#pragma unroll
            for (int k2 = 0; k2 < 4; ++k2) { bfx8 sf[2][4];
#pragma unroll
                for (int kq = 0; kq < 2; ++kq)
#pragma unroll
                    for (int vt = 0; vt < 4; ++vt) sf[kq][vt] = *(const LAS bfx8*)(SF + (((2 * k2 + kq) * 4 + vt) * 64 + lane) * 16);
                __builtin_amdgcn_sched_barrier(0);
#pragma unroll
                for (int kq = 0; kq < 2; ++kq)
#pragma unroll
                    for (int vt = 0; vt < 4; ++vt) oacc[vt] = MFMA16(sf[kq][vt], qf[2 * k2 + kq], oacc[vt]);
                __builtin_amdgcn_sched_barrier(0); }
#pragma unroll
            for (int kk = 0; kk < 4; ++kk) if (2 * kk <= tt) { const bfx8 pf = pack8(pacc[2 * kk], pacc[2 * kk + 1]);
                bfx8 vf[4];
#pragma unroll
                for (int vt = 0; vt < 4; ++vt) { LAS unsigned char* p0 = VS + (32 * kk + 4 * q + (l15 >> 2)) * RT_PV + (16 * vt + 4 * (l15 & 3)) * 2; vf[vt] = cat8(ds_tr(p0), ds_tr(p0 + 16 * RT_PV)); }
                __builtin_amdgcn_sched_barrier(0);
#pragma unroll
                for (int vt = 0; vt < 4; ++vt) oacc[vt] = MFMA16(vf[vt], pf, oacc[vt]); }
            { const size_t row = (size_t)(rowbase + 16 * tt + l15); float ss = 0.f;
#pragma unroll
              for (int vt = 0; vt < 4; ++vt) { const f32x4 o = oacc[vt]; ss += (o[0] * o[0] + o[1] * o[1]) + (o[2] * o[2] + o[3] * o[3]);
                  v2u w; w.x = pg8::cvt_pk_bf16(o[0], o[1]); w.y = pg8::cvt_pk_bf16(o[2], o[3]); *(v2u*)(VO + row * (RH * RDV) + h * RDV + js * 64 + 16 * vt + 4 * q) = w; }
              ss += shx(ss, 16, lane); ss += shx(ss, 32, lane);
              if (q == 0) rstat[(row * RH + h) * 8 + js] = ss; }
#pragma unroll
            for (int ks = 0; ks < 8; ++ks) qf[ks] = *(const bfx8*)(qbase + (size_t)(nn * CH) * D * 2 + 64 * ks + qoff);
#pragma unroll
            for (int kk = 0; kk < 4; ++kk) { bfx8 vfn[4];
#pragma unroll
                for (int vt = 0; vt < 4; ++vt) { LAS unsigned char* p0 = VS + (32 * kk + 8 * q + (l15 >> 2)) * RT_PV + (16 * vt + 4 * (l15 & 3)) * 2; vfn[vt] = cat8(ds_tr(p0), ds_tr(p0 + 4 * RT_PV)); }
                bfx8 af[2];
#pragma unroll
                for (int ci = 0; ci < 2; ++ci) { LAS unsigned char* p0 = KS + (32 * kk + 8 * q + (l15 >> 2)) * RT_PK + (32 * wave + 8 * (l15 & 3) + 4 * ci) * 2; af[ci] = cat8(ds_tr(p0), ds_tr(p0 + 4 * RT_PK)); }
                __builtin_amdgcn_sched_barrier(0);
#pragma unroll
                for (int ci = 0; ci < 2; ++ci)
#pragma unroll
                    for (int vt = 0; vt < 4; ++vt) S[ci][vt] = MFMA16(af[ci], vfn[vt], S[ci][vt]);
                __builtin_amdgcn_sched_barrier(0); }
#pragma unroll
            for (int ci = 0; ci < 2; ++ci)
#pragma unroll
                for (int vt = 0; vt < 4; ++vt) S[ci][vt] = S[ci][vt] * cd;
            __syncthreads();
#pragma unroll
            for (int vt = 0; vt < 4; ++vt) *(LAS bfx8*)(SF + ((wave * 4 + vt) * 64 + lane) * 16) = pack8(S[0][vt], S[1][vt]);
#pragma unroll
            for (int i = 0; i < 8; ++i) { const int p = tid + 512 * i; *(LAS v4u*)(KS + (p >> 5) * RT_PK + (p & 31) * 16) = kr[i]; }
#pragma unroll
            for (int i = 0; i < 2; ++i) { const int p = tid + 512 * i; *(LAS v4u*)(VS + (p >> 3) * RT_PV + (p & 7) * 16) = vr[i]; }
            __syncthreads();
        }
    }
}
__device__ __forceinline__ void ognorm_phase(const bf16* O, const bf16* Gs, const float* rstat, signed char* OG8, float* SA, int gw, int NGW, int lane) {
    float stn[2]; v4u ovn[2][RH], gvn[2][RH];
#define OGN_LOAD(mm) _Pragma("unroll") for (int r = 0; r < 2; ++r) { stn[r] = rstat[(size_t)((mm) + r) * (RH * 8) + (lane & 31)]; \
        _Pragma("unroll") for (int h = 0; h < RH; ++h) { const size_t off = (size_t)((mm) + r) * (RH * RDV) + h * RDV + lane * 8; ovn[r][h] = *(const v4u*)(O + off); gvn[r][h] = *(const v4u*)(Gs + off); } }
    OGN_LOAD(2 * gw)
    for (int m0 = 2 * gw; m0 < M; m0 += 2 * NGW) {
        float st[2]; v4u ov[2][RH], gv[2][RH];
#pragma unroll
        for (int r = 0; r < 2; ++r) { st[r] = stn[r];
#pragma unroll
            for (int h = 0; h < RH; ++h) { ov[r][h] = ovn[r][h]; gv[r][h] = gvn[r][h]; } }
        { const int mn = m0 + 2 * NGW < M ? m0 + 2 * NGW : m0; OGN_LOAD(mn) }
#pragma unroll
        for (int r = 0; r < 2; ++r) {
            float s8 = st[r]; s8 += dpp_f<0xB1>(s8); s8 += dpp_f<0x4E>(s8); s8 += dpp_f<0x141>(s8);
            const float rq = 1.0f / sqrtf(s8 * (1.0f / RDV) + EPS);
            float v[RH][8]; float am = 0.f;
#pragma unroll
            for (int h = 0; h < RH; ++h) { const float rr = rdl_f(rq, 8 * h); const v4u o4 = ov[r][h], g4 = gv[r][h];
                v[h][0] = bflo(o4.x) * rr * pg8::silu_f(bflo(g4.x)); v[h][1] = bfhi(o4.x) * rr * pg8::silu_f(bfhi(g4.x)); v[h][2] = bflo(o4.y) * rr * pg8::silu_f(bflo(g4.y)); v[h][3] = bfhi(o4.y) * rr * pg8::silu_f(bfhi(g4.y));
                v[h][4] = bflo(o4.z) * rr * pg8::silu_f(bflo(g4.z)); v[h][5] = bfhi(o4.z) * rr * pg8::silu_f(bfhi(g4.z)); v[h][6] = bflo(o4.w) * rr * pg8::silu_f(bflo(g4.w)); v[h][7] = bfhi(o4.w) * rr * pg8::silu_f(bfhi(g4.w));
#pragma unroll
                for (int e = 0; e < 8; ++e) am = fmaxf(am, fabsf(v[h][e])); }
            am = wave_max(am, lane); const float inv = am > 0.f ? 127.0f / am : 0.f;
#pragma unroll
            for (int h = 0; h < RH; ++h) { unsigned w0 = 0u, w1 = 0u;
#pragma unroll
                for (int e = 0; e < 4; ++e) { const int q0 = (int)__builtin_rintf(v[h][e] * inv), q1 = (int)__builtin_rintf(v[h][4 + e] * inv); w0 |= ((unsigned)q0 & 0xffu) << (8 * e); w1 |= ((unsigned)q1 & 0xffu) << (8 * e); }
                v2u o; o.x = w0; o.y = w1; *(v2u*)(OG8 + (size_t)(m0 + r) * (RH * RDV) + h * RDV + lane * 8) = o; }
            if (lane == 0) SA[m0 + r] = am * (1.0f / 127.0f);
        }
    }
}
__device__ __forceinline__ void route_phase(bf16* X, const bf16* delta, const float* g, const float* msh, const float* ms, const float* wr, const float* br, signed char* XN, float* SA, v4u* route, int* table,
                                            LAS unsigned char* lds, int tid, int lane, int wave, int bid, int G) {
    LAS int* cnt = (LAS int*)lds;
    f32x4 wq[4][4][2], gq[4];
#pragma unroll
    for (int j = 0; j < 4; ++j) { gq[j] = ((const f32x4*)g + lane)[64 * j];
        const f32x4* wp = (const f32x4*)(wr + (size_t)((lane + 64 * j) * 4) * NE);
#pragma unroll
        for (int qq = 0; qq < 4; ++qq) { wq[j][qq][0] = wp[2 * qq]; wq[j][qq][1] = wp[2 * qq + 1]; } }
    for (int blk = bid; blk < M / 128; blk += G) {
        __syncthreads();
        if (tid < 8) cnt[tid] = 0;
        __syncthreads();
        const int b = (blk * 128) / SEQ;
        f32x4 ga[4], hv[4];
        { const f32x4* sp = (const f32x4*)(ms + (size_t)b * MODW) + lane; const f32x4* hp = (const f32x4*)(msh + (size_t)b * MODW) + lane;
#pragma unroll
          for (int j = 0; j < 4; ++j) { ga[j] = gq[j] * (1.0f + sp[64 * j]); hv[j] = hp[64 * j]; } }
        for (int i = 0; i < 16; ++i) {
            const int m = blk * 128 + wave * 16 + i;
            v2u* xr = (v2u*)(X + (size_t)m * D) + lane;
            f32x4 v[4]; float ss = 0.f;
#pragma unroll
            for (int j = 0; j < 4; ++j) { const v2u xx = xr[64 * j]; const v2u dd = ((const v2u*)(delta + (size_t)m * D) + lane)[64 * j];
                v2u w; w.x = pk2(bflo(xx.x) + bflo(dd.x), bfhi(xx.x) + bfhi(dd.x)); w.y = pk2(bflo(xx.y) + bflo(dd.y), bfhi(xx.y) + bfhi(dd.y)); xr[64 * j] = w;
                v[j] = (f32x4){bflo(w.x), bfhi(w.x), bflo(w.y), bfhi(w.y)};
                ss += (v[j].x * v[j].x + v[j].y * v[j].y) + (v[j].z * v[j].z + v[j].w * v[j].w); }
            const float rstd = 1.0f / sqrtf(wave_sum(ss, lane) * (1.0f / D) + EPS);
            float lg[NE]; f32x4 oo[4];
#pragma unroll
            for (int e = 0; e < NE; ++e) lg[e] = 0.f;
#pragma unroll
            for (int j = 0; j < 4; ++j) { const f32x4 o = v[j] * rstd * ga[j] + hv[j]; oo[j] = o;
#pragma unroll
                for (int qq = 0; qq < 4; ++qq) { const f32x4 w0 = wq[j][qq][0], w1 = wq[j][qq][1]; const float hk = o[qq];
                    lg[0] += hk * w0.x; lg[1] += hk * w0.y; lg[2] += hk * w0.z; lg[3] += hk * w0.w; lg[4] += hk * w1.x; lg[5] += hk * w1.y; lg[6] += hk * w1.z; lg[7] += hk * w1.w; } }
#pragma unroll
            for (int e = 0; e < NE; ++e) lg[e] = wave_sum(lg[e], lane) + br[e];
            { const float sc = quant_row_store(oo, XN + (size_t)m * D, lane); if (lane == 0) SA[m] = sc; }
            int i1 = 0; float l1 = lg[0];
#pragma unroll
            for (int e = 1; e < NE; ++e) if (lg[e] > l1) { l1 = lg[e]; i1 = e; }
            int i2 = -1; float l2 = -3.0e38f;
#pragma unroll
            for (int e = 0; e < NE; ++e) if (e != i1 && lg[e] > l2) { l2 = lg[e]; i2 = e; }
            const float w1 = 1.0f / (1.0f + __expf(l2 - l1)), w2 = 1.0f - w1;
            if (lane == 0) { v4u r; r.x = (unsigned)i1; r.y = (unsigned)i2; r.z = __builtin_bit_cast(unsigned, w1); r.w = __builtin_bit_cast(unsigned, w2); route[m] = r;
                atomicAdd((int*)(cnt + i1), 1); atomicAdd((int*)(cnt + i2), 1); }
        }
        __syncthreads();
        if (tid < 8) table[blk * 8 + tid] = cnt[tid];
    }
}
__device__ __forceinline__ void sort_phase(const v4u* route, const int* table, const float* SA, unsigned char* listb, LAS unsigned char* lds, int tid, int bid, int G) {
    LAS int* tab = (LAS int*)lds;
    LAS int* ptot = (LAS int*)(lds + 8192);
    LAS int* pmine = (LAS int*)(lds + 8192 + 2048);
    LAS int* tot = (LAS int*)(lds + 8192 + 4096);
    LAS int* ex = (LAS int*)(lds + 8192 + 4096 + 256);
    int* idx = (int*)(listb + LIST_IDX); float* gwt = (float*)(listb + LIST_GW); int* tile_e = (int*)(listb + LIST_TE); int* ntl = (int*)(listb + LIST_NT); float* sal = (float*)(listb + LIST_SAL);
    for (int blk = bid; blk < M / 128; blk += G) {
        __syncthreads();
        for (int i = tid; i < (M / 128) * 8; i += 512) tab[i] = table[i];
        __syncthreads();
        { const int e = tid & 7, part = tid >> 3; int a = 0, mn = 0;
#pragma unroll
          for (int k = 0; k < 4; ++k) { const int bb = part * 4 + k; const int v = tab[bb * 8 + e]; a += v; if (bb < blk) mn += v; }
          ptot[part * 8 + e] = a; pmine[part * 8 + e] = mn; }
        __syncthreads();
        if (tid < 8) { int a = 0, mn = 0; for (int k = 0; k < 64; ++k) { a += ptot[k * 8 + tid]; mn += pmine[k * 8 + tid]; } tot[tid] = a; tot[8 + tid] = mn; }
        v4u r = (v4u){0u, 0u, 0u, 0u};
        if (tid < 128) { r = route[blk * 128 + tid]; ex[tid] = (int)r.x; ex[128 + tid] = (int)r.y; }
        __syncthreads();
        if (tid == 0) { int base = 0; for (int e = 0; e < NE; ++e) { tot[16 + e] = base; const int nt = (tot[e] + 255) >> 8;
                if (blk == 0) for (int k = 0; k < nt; ++k) tile_e[(base >> 8) + k] = e;
                base += nt * 256; }
            if (blk == 0) ntl[0] = base >> 8; }
        if (tid >= 64 && tid < 72) { const int e = tid - 64; int c = 0; for (int k = 0; k < 128; ++k) c += (ex[k] == e) ? 1 : 0; tot[24 + e] = c; }
        __syncthreads();
        if (blk == 0 && tid < 256) { for (int e = 0; e < NE; ++e) { const int n = tot[e], base = tot[16 + e]; const int pos = base + n + tid; if (pos < base + ((n + 255) & ~255)) { idx[pos] = -1; gwt[pos] = 0.f; sal[pos] = 0.f; } } }
        if (tid < 128) { const int e1 = (int)r.x, e2 = (int)r.y; int r1 = 0, r2 = 0;
            for (int k = 0; k < tid; ++k) { r1 += (ex[k] == e1) ? 1 : 0; r2 += (ex[128 + k] == e2) ? 1 : 0; }
            const int p1 = tot[16 + e1] + tot[8 + e1] + r1, p2 = tot[16 + e2] + tot[8 + e2] + tot[24 + e2] + r2; const int tok = blk * 128 + tid;
            const float sat = SA[tok]; idx[p1] = 2 * tok; gwt[p1] = u2f(r.z); sal[p1] = sat; idx[p2] = 2 * tok + 1; gwt[p2] = u2f(r.w); sal[p2] = sat; }
    }
}
__device__ __forceinline__ void final_phase(float* out, const bf16* X16, const bf16* P0, const bf16* P1, const float* g, const float* gate, int gw, int NGW, int lane) {
    const int wpb = NGW / NB, b = gw / wpb, r0 = gw - b * wpb;
    if (b >= NB) return;
    f32x4 gv[4], gt[4];
#pragma unroll
    for (int j = 0; j < 4; ++j) { gv[j] = ((const f32x4*)g + lane)[64 * j]; gt[j] = ((const f32x4*)(gate + (size_t)b * MODW) + lane)[64 * j]; }
    for (int r = r0; r < SEQ; r += 2 * wpb) {
        int mm[2]; mm[0] = b * SEQ + r; mm[1] = b * SEQ + (r + wpb < SEQ ? r + wpb : r);
        v2u x[2][4], a[2][4], c[2][4];
#pragma unroll
        for (int q = 0; q < 2; ++q)
#pragma unroll
            for (int j = 0; j < 4; ++j) { x[q][j] = ((const v2u*)(X16 + (size_t)mm[q] * D) + lane)[64 * j]; a[q][j] = ((const v2u*)(P0 + (size_t)mm[q] * D) + lane)[64 * j]; c[q][j] = ((const v2u*)(P1 + (size_t)mm[q] * D) + lane)[64 * j]; }
#pragma unroll
        for (int q = 0; q < 2; ++q) { f32x4 v[4]; float ss = 0.f;
#pragma unroll
            for (int j = 0; j < 4; ++j) { const v2u xx = x[q][j], aa = a[q][j], bb = c[q][j];
                v[j].x = bflo(xx.x) + gt[j].x * (bflo(aa.x) + bflo(bb.x)); v[j].y = bfhi(xx.x) + gt[j].y * (bfhi(aa.x) + bfhi(bb.x)); v[j].z = bflo(xx.y) + gt[j].z * (bflo(aa.y) + bflo(bb.y)); v[j].w = bfhi(xx.y) + gt[j].w * (bfhi(aa.y) + bfhi(bb.y));
                ss += (v[j].x * v[j].x + v[j].y * v[j].y) + (v[j].z * v[j].z + v[j].w * v[j].w); }
            const float rstd = 1.0f / sqrtf(wave_sum(ss, lane) * (1.0f / D) + EPS);
            f32x4* o = (f32x4*)(out + (size_t)mm[q] * D) + lane;
#pragma unroll
            for (int j = 0; j < 4; ++j) o[64 * j] = v[j] * rstd * gv[j]; }
    }
}

__device__ __forceinline__ const void* karg(int i) { typedef const GAS void* gptr_t; const __attribute__((address_space(4))) gptr_t* ka = (const __attribute__((address_space(4))) gptr_t*)__builtin_amdgcn_kernarg_segment_ptr(); asm volatile("" : "+s"(ka)); return (const void*)ka[i]; }
struct Args { const void* in[22]; float* out; unsigned char* ws; };
__global__ void __launch_bounds__(512, 2) fwd(Args a) {
    extern __shared__ __attribute__((aligned(16))) unsigned char lds_raw[];
    LAS unsigned char* lds = (LAS unsigned char*)lds_raw;
    const int G = gridDim.x, bid = blockIdx.x;
    const int vcu = (G % 8 == 0) ? (bid % 8) * (G / 8) + bid / 8 : bid;
    const int NGW = G * 8;
    const int wave0 = __builtin_amdgcn_readfirstlane((int)threadIdx.x >> 6);
#define FRESH_TID() (wave0 * 64 + fresh_lane())
#define FRESH_IDS() int tid = FRESH_TID(); asm volatile("" : "+v"(tid)); const int lane = tid & 63, wave = wave0; const int gw = vcu * 8 + wave; (void)lane; (void)gw
    unsigned char* const ws0 = a.ws;
#define WS_LOCAL() GAS unsigned char* wsg_ = (GAS unsigned char*)ws0; asm volatile("" : "+s"(wsg_)); unsigned char* ws = (unsigned char*)wsg_
    unsigned char* ws = ws0;
    unsigned* ctl = (unsigned*)(ws + WS_CTL);
    for (int u = threadIdx.x; u < (LDS_BYTES - LDSCTL_OFF) / 4; u += 512) ((LAS unsigned*)(lds + LDSCTL_OFF))[u] = 0u;
    __syncthreads();
    XcdBarrier bar = xcd_barrier_post(ctl + CW_BAR, (volatile LAS unsigned*)(lds + MISC_OFF) + 8);

    float* X = a.out;
    float* MOD = (float*)(ws + WS_MOD);
    signed char* XN = (signed char*)(ws + WS_XN); float* SA = (float*)(ws + WS_SA); const float* SW = (const float*)(ws + WS_SW);
    const float* MOD0 = MOD; const float* MOD1 = MOD + (size_t)NB * MODW;

    { FRESH_IDS(); WS_LOCAL(); mod_phase((const float*)karg(1), (const float*)karg(3), (const float*)karg(4), MOD, lds, tid, lane, wave, bid, G); }
    { FRESH_IDS(); WS_LOCAL(); const WPtrs WP{(const float*)karg(7), (const float*)karg(12), (const float*)karg(13), (const float*)karg(14), (const float*)karg(15), (const float*)karg(16), (const float*)karg(19), (const float*)karg(20)}; cvt_phase_a(WP, ws, lds, gw, NGW, wave, lane); }
    xcd_barrier(bar);
    int vid = bid;
    { volatile LAS unsigned* stw = (volatile LAS unsigned*)(lds + MISC_OFF) + 8;
      if (threadIdx.x == 0) { unsigned ok = (G % 8 == 0) ? 1u : 0u, below = 0u, npop = 0u;
          for (unsigned j = 0; j < 16; ++j) { const unsigned cnt = xb_ld(&ctl[CW_BAR + XB_XCNT(j)]); if (cnt != 0u) { ++npop; if (cnt != (unsigned)G / 8u) ok = 0u; if (j < bar.x) ++below; } }
          if (npop != 8u) ok = 0u;
          stw[3] = ok ? (stw[2] * 8u + below) : (unsigned)bid; }
      __syncthreads();
      vid = __builtin_amdgcn_readfirstlane((int)stw[3]); }
    { FRESH_IDS(); WS_LOCAL(); const WPtrs WP{(const float*)karg(7), (const float*)karg(12), (const float*)karg(13), (const float*)karg(14), (const float*)karg(15), (const float*)karg(16), (const float*)karg(19), (const float*)karg(20)}; cvt_phase_b(WP, ws, lds, bid, G, tid); }
    { FRESH_IDS(); WS_LOCAL(); norm_phase<false>(karg(0), nullptr, nullptr, ((const float*)karg(5)), MOD0 + 0, MOD0 + D, XN, SA, gw, NGW, lane); }
    xcd_barrier(bar);
    { WS_LOCAL(); pg8::Gemm g{(const bf16*)XN, (const bf16*)(ws + WS_W_SGU_IN), D}; pg8::StaticOrder S; S.init(M / 256, 2 * SGW / 256, G, vid, nullptr, nullptr);
      pg8::EpiSguIn E{(bf16*)(ws + WS_U), (bf16*)(ws + WS_V), (float2*)(ws + WS_VSTAT), SA, SW + SW_SGU};
      pg8::gemm_phase<pg8::EpiSguIn, pg8::StaticOrder, true, false, true>(lds, g, S, E, FRESH_TID()); }
    xcd_barrier(bar);
    { FRESH_IDS(); WS_LOCAL(); sgate_mfma((bf16*)(ws + WS_U), (const bf16*)(ws + WS_V), (const float2*)(ws + WS_VSTAT), (const float*)karg(8), (const float*)karg(9), (const float*)karg(10), (const float*)karg(11), lds, tid, bid, G); }
    xcd_barrier(bar);
    { WS_LOCAL(); pg8::Gemm g{(const bf16*)(ws + WS_U), (const bf16*)(ws + WS_W_SGU_OUT), SGW}; pg8::StaticOrder S; S.init(M / 256, D / 256, G, vid, nullptr, nullptr);
      pg8::EpiDelta E{(bf16*)(ws + WS_DELTA), MOD0 + 2 * D, nullptr, nullptr};
      pg8::gemm_phase<pg8::EpiDelta, pg8::StaticOrder, true, false>(lds, g, S, E, FRESH_TID()); }
    xcd_barrier(bar);
    { FRESH_IDS(); WS_LOCAL(); norm_phase<false>(karg(0), (const bf16*)(ws + WS_DELTA), (bf16*)(ws + WS_X16), ((const float*)karg(6)), MOD0 + 3 * D, MOD0 + 4 * D, XN, SA, gw, NGW, lane); }
    xcd_barrier(bar);
    { WS_LOCAL(); pg8::Gemm g{(const bf16*)XN, (const bf16*)(ws + WS_W_FFN_GU), D}; pg8::StaticOrder S; S.init(M / 256, 2 * FF / 256, G, vid, nullptr, nullptr);
      pg8::EpiSwigluF8 E{(unsigned char*)(ws + WS_ACT), FF, SA, SW + SW_FFN};
      pg8::gemm_phase<pg8::EpiSwigluF8, pg8::StaticOrder, true, false, true>(lds, g, S, E, FRESH_TID()); }
    xcd_barrier(bar);
    { WS_LOCAL(); pg8::Gemm g{(const bf16*)(ws + WS_ACT), (const bf16*)(ws + WS_W_FFN_DN), FF}; pg8::StaticOrder S; S.init(M / 256, D / 256, G, vid, nullptr, nullptr);
      pg8::EpiDeltaF8 E{(bf16*)(ws + WS_DELTA), MOD0 + 5 * D, SW + SW_FD, 1.0f / pg8::ACT_F8};
      pg8::gemm_phase<pg8::EpiDeltaF8, pg8::StaticOrder, true, false, false, true>(lds, g, S, E, FRESH_TID()); }
    xcd_barrier(bar);
    { FRESH_IDS(); WS_LOCAL(); norm_phase<true>(ws + WS_X16, (const bf16*)(ws + WS_DELTA), (bf16*)(ws + WS_X16), ((const float*)karg(5)) + D, MOD1 + 0, MOD1 + D, XN, SA, gw, NGW, lane); }
    xcd_barrier(bar);
    { WS_LOCAL(); pg8::Gemm g{(const bf16*)XN, (const bf16*)(ws + WS_W_RET_IN), D}; pg8::StaticOrder S; S.init(M / 256, RET_IN / 256, G, vid, nullptr, nullptr);
      pg8::EpiRetIn E{(bf16*)(ws + WS_Q), (bf16*)(ws + WS_K), (bf16*)(ws + WS_RV), (bf16*)(ws + WS_G), (const int*)karg(2), SA, SW + SW_RET};
      pg8::gemm_phase<pg8::EpiRetIn, pg8::StaticOrder, true, false, true>(lds, g, S, E, FRESH_TID()); }
    xcd_barrier(bar);
    { FRESH_IDS(); WS_LOCAL(); ret_mfma((const bf16*)(ws + WS_Q), (const bf16*)(ws + WS_K), (bf16*)(ws + WS_RV), (float*)(ws + WS_RSTAT), lds, tid, vid, G); }
    xcd_barrier(bar);
    { FRESH_IDS(); WS_LOCAL(); ognorm_phase((const bf16*)(ws + WS_RV), (const bf16*)(ws + WS_G), (const float*)(ws + WS_RSTAT), (signed char*)(ws + WS_Q), SA, gw, NGW, lane); }
    xcd_barrier(bar);
    { WS_LOCAL(); pg8::Gemm g{(const bf16*)(ws + WS_Q), (const bf16*)(ws + WS_W_RET_OUT), RH * RDV}; pg8::StaticOrder S; S.init(M / 256, D / 256, G, vid, nullptr, nullptr);
      pg8::EpiDelta E{(bf16*)(ws + WS_DELTA), MOD1 + 2 * D, SA, SW + SW_RO};
      pg8::gemm_phase<pg8::EpiDelta, pg8::StaticOrder, true, false, true>(lds, g, S, E, FRESH_TID()); }
    xcd_barrier(bar);
    { FRESH_IDS(); WS_LOCAL(); route_phase((bf16*)(ws + WS_X16), (const bf16*)(ws + WS_DELTA), ((const float*)karg(6)) + D, MOD1 + 3 * D, MOD1 + 4 * D, (const float*)karg(17), (const float*)karg(18), XN, SA, (v4u*)(ws + WS_ROUTE), (int*)(ws + WS_RTAB), lds, tid, lane, wave, bid, G); }
    xcd_barrier(bar);
    { FRESH_IDS(); WS_LOCAL(); sort_phase((const v4u*)(ws + WS_ROUTE), (const int*)(ws + WS_RTAB), SA, ws + WS_LIST, lds, tid, bid, G); }
    xcd_barrier(bar);
    { WS_LOCAL(); const int* idx = (const int*)(ws + WS_LIST + LIST_IDX); const int* tile_e = (const int*)(ws + WS_LIST + LIST_TE); const int ntl = __builtin_amdgcn_readfirstlane(*(const int*)(ws + WS_LIST + LIST_NT));
      pg8::Gemm g{(const bf16*)XN, (const bf16*)(ws + WS_W_MOE_GU), D}; pg8::StaticOrder S; S.init(ntl, 2 * FF / 256, G, vid, tile_e, idx);
      pg8::EpiSwigluF8 E{(unsigned char*)(ws + WS_ACT), FF, (const float*)(ws + WS_LIST + LIST_SAL), SW + SW_MOE};
      pg8::gemm_phase<pg8::EpiSwigluF8, pg8::StaticOrder, true, true, true>(lds, g, S, E, FRESH_TID()); }
    xcd_barrier(bar);
    { WS_LOCAL(); const int* idx = (const int*)(ws + WS_LIST + LIST_IDX); const float* gwt = (const float*)(ws + WS_LIST + LIST_GW); const int* tile_e = (const int*)(ws + WS_LIST + LIST_TE); const int ntl = __builtin_amdgcn_readfirstlane(*(const int*)(ws + WS_LIST + LIST_NT));
      pg8::Gemm g{(const bf16*)(ws + WS_ACT), (const bf16*)(ws + WS_W_MOE_DN), FF}; pg8::StaticOrder S; S.init(ntl, D / 256, G, vid, tile_e, nullptr);
      pg8::EpiMoeDown E{(bf16*)(ws + WS_P0), ((long long)WS_P1 - (long long)WS_P0) / 2, idx, gwt, SW + SW_MD, 1.0f / pg8::ACT_F8};
      pg8::gemm_phase<pg8::EpiMoeDown, pg8::StaticOrder, true, false, false, true>(lds, g, S, E, FRESH_TID()); }
    xcd_barrier(bar);
    { FRESH_IDS(); WS_LOCAL(); final_phase(X, (const bf16*)(ws + WS_X16), (const bf16*)(ws + WS_P0), (const bf16*)(ws + WS_P1), (const float*)karg(21), MOD1 + 5 * D, gw, NGW, lane); }
}

extern "C" void kernel_launch(void* const* d_in, const int* in_sizes, int n_in, void* d_out, int out_size, void* d_ws, size_t ws_size, hipStream_t stream) {
    static int grid = 0;
    if (grid == 0) {
        if (n_in != 22 || in_sizes[0] != M * D || out_size != M * D || ws_size < WS_END) { fprintf(stderr, "kernel_launch: unexpected shapes (n_in %d, in0 %d, out %d, ws %zu < %zu)\n", n_in, n_in > 0 ? in_sizes[0] : -1, out_size, ws_size, (size_t)WS_END); grid = -1; return; }
        int dev = 0, cus = 0, per_cu = 0;
        if (hipGetDevice(&dev) != hipSuccess || hipDeviceGetAttribute(&cus, hipDeviceAttributeMultiprocessorCount, dev) != hipSuccess) { grid = -1; return; }
        if (hipFuncSetAttribute((const void*)fwd, hipFuncAttributeMaxDynamicSharedMemorySize, LDS_BYTES) != hipSuccess) { fprintf(stderr, "kernel_launch: hipFuncSetAttribute failed\n"); grid = -1; return; }
        if (hipOccupancyMaxActiveBlocksPerMultiprocessor(&per_cu, (const void*)fwd, 512, LDS_BYTES) != hipSuccess || per_cu < 1) fprintf(stderr, "kernel_launch: occupancy query says %d\n", per_cu);
        (void)hipGetLastError();
        grid = cus;
    }
    if (grid < 0) return;
    if (hipMemsetAsync((char*)d_ws + WS_CTL, 0, CTL_ZERO_BYTES, stream) != hipSuccess) return;
    Args a{};
    for (int i = 0; i < 22; ++i) a.in[i] = d_in[i];
    a.out = (float*)d_out; a.ws = (unsigned char*)d_ws;
    hipLaunchKernelGGL(fwd, dim3(grid), dim3(512), LDS_BYTES, stream, a);
}
```

```cpp
#include <hip/hip_runtime.h>
#include <cstdio>
#include <cstdint>

constexpr int D = 1024, NB = 8, SEQ = 4096, M = NB * SEQ;
constexpr int CH = 128, SGW = 2048, NGRP = 8;
constexpr int RH = 4, RDK = 256, RDV = 512, RET_IN = 6144;
constexpr int FF = 2816, NE = 8;
constexpr float EPS = 1e-6f;
constexpr int MODW = 6 * D;
constexpr int LCAP = 2 * M + NE * 256;
constexpr int LTILES = LCAP / 256;

typedef unsigned short bf16;
#define LAS __attribute__((address_space(3)))
#define GAS __attribute__((address_space(1)))
__device__ __forceinline__ float shx(float v, int k, int lane) { return __builtin_bit_cast(float, __builtin_amdgcn_ds_bpermute((lane ^ k) << 2, __builtin_bit_cast(int, v))); }

__device__ __forceinline__ int fresh_lane() { int l; asm volatile("v_mbcnt_lo_u32_b32 %0, -1, 0\n\tv_mbcnt_hi_u32_b32 %0, -1, %0" : "=v"(l)); return l; }
namespace pg8 {
#define PG8_LAS __attribute__((address_space(3)))
constexpr int EPI_SLOT_OFF = 131072 + 1024;
typedef unsigned short bf16_t;
typedef short bf16x8 __attribute__((ext_vector_type(8)));
typedef float f32x4 __attribute__((ext_vector_type(4)));
typedef unsigned u32x4 __attribute__((ext_vector_type(4)));
typedef unsigned u32x2 __attribute__((ext_vector_type(2)));
constexpr int BM = 256, BK = 64, HALF = 128, HTB = HALF * BK * 2, STAGE_BYTES = 8 * HTB, NXCD = 8, WGM = 4;

__host__ __device__ __forceinline__ int lds_byte(int r, int c) { const int st = (r >> 4) * 2 + (c >> 5), rr = r & 15, cc = c & 31, ob = rr * 64 + cc * 2; return st * 1024 + (ob ^ (((ob >> 9) & 1) << 5)); }
__host__ __device__ __forceinline__ void stage_rc(int b, int& R, int& C) { const int st = b / 1024, sb = b % 1024, swz = sb ^ (((sb >> 9) & 1) << 5); R = (st >> 1) * 16 + swz / 64; C = (st & 1) * 32 + (swz % 64) / 2; }
__host__ __device__ __forceinline__ int perm32(int rho) { const int n = rho >> 4, i = rho & 15; return 8 * (i >> 2) + 4 * n + (i & 3); }

struct Unit { int pm, pn, pb; };
struct Gemm { const bf16_t* A; const bf16_t* Bt; int K; };

struct StaticOrder {
    int nM, nN, nwg, G, c; const int* tile_e; const int* rowmap;
    __device__ void init(int nM_, int nN_, int G_, int c_, const int* te, const int* rm) { nM = nM_; nN = nN_; nwg = nM * nN; G = G_; c = c_; tile_e = te; rowmap = rm; }
    __device__ bool next(int i, Unit& u) const {
        const long L = (long)i * G + c; if (L >= nwg) return false;
        int wgid = (int)L; { const int q = nwg / NXCD, r = nwg % NXCD, xcd = wgid % NXCD, off = wgid / NXCD; wgid = (xcd < r ? xcd * (q + 1) : r * (q + 1) + (xcd - r) * q) + off; }
        const int nig = WGM * nN, gid = wgid / nig, fm = gid * WGM, gsz = (nM - fm) < WGM ? (nM - fm) : WGM;
        u.pm = fm + ((wgid % nig) % gsz); u.pn = (wgid % nig) / gsz;
        u.pb = tile_e ? __builtin_amdgcn_readfirstlane(tile_e[u.pm]) * nN + u.pn : u.pn; return true;
    }
};

__device__ __forceinline__ unsigned cvt_pk_bf16(float lo, float hi) { unsigned r; asm volatile("v_cvt_pk_bf16_f32 %0, %1, %2" : "=v"(r) : "v"(lo), "v"(hi)); return r; }

typedef int i32x4 __attribute__((ext_vector_type(4)));
typedef int i32x8 __attribute__((ext_vector_type(8)));
typedef short bf16x16 __attribute__((ext_vector_type(16)));
#ifndef F8SCALE
#define F8SCALE 0
#endif
template <bool I8> struct AccT { typedef f32x4 type; };
template <> struct AccT<true> { typedef i32x4 type; };
template <class Epi, class Sched, bool ALIGN_EPI, bool GATHER, bool I8 = false, bool F8 = false>
__device__ __forceinline__ void gemm_phase(PG8_LAS unsigned char* lds, const Gemm g, const Sched& S, const Epi& E, int tid_) {
    asm volatile("" : "+v"(tid_));
    const int tid = tid_, wid = __builtin_amdgcn_readfirstlane(tid >> 6), lane = tid & 63, wr = wid >> 2, wc = wid & 3, fr = lane & 15, fq = lane >> 4;
    const int K = (I8 || F8) ? g.K : 2 * g.K  , nt = K / 128;
    int R0, C0; stage_rc(tid * 16, R0, C0); C0 *= 2;
    unsigned voffB[2];
    { const int Rb = Epi::PERM ? ((R0 & ~31) + perm32(R0 & 31)) : R0; voffB[0] = (unsigned)(Rb * K + C0); voffB[1] = voffB[0] + (unsigned)(64 * K); }
    const size_t kstep = (size_t)128;
    const size_t hstep = (size_t)HALF * K;
    const size_t tstep = 2 * hstep;
    const unsigned ldsw = (unsigned)wid * 1024u;
    const int aoff = lds_byte(wr * 64 + fr, fq * 8), boff = lds_byte(wc * 32 + fr, fq * 8);
#define PG8_SA(b, h) (((b) * 2 + (h)) * HTB)
#define PG8_SB(b, h) ((4 + (b) * 2 + (h)) * HTB)
#define PG8_STAGE(bufoff, gbase, voff) do { _Pragma("unroll") for (int _i = 0; _i < 2; ++_i) \
        __builtin_amdgcn_global_load_lds((const unsigned*)((const char*)(gbase) + (voff)[_i]), (PG8_LAS unsigned*)(lds + (bufoff) + ldsw + _i * 8192), 16, 0, 0); } while (0)
#define PG8_LDA(dst, b, h) do { if constexpr (F8) { _Pragma("unroll") for (int m = 0; m < 4; ++m) dst##x[m] = __builtin_shufflevector(*(const PG8_LAS bf16x8*)(lds + PG8_SA(b, h) + aoff + m * 2048), *(const PG8_LAS bf16x8*)(lds + PG8_SA(b, h) + aoff + m * 2048 + 1024), 0, 1, 2, 3, 4, 5, 6, 7, 8, 9, 10, 11, 12, 13, 14, 15); } \
        else { _Pragma("unroll") for (int m = 0; m < 4; ++m) _Pragma("unroll") for (int k = 0; k < 2; ++k) dst[m][k] = *(const PG8_LAS bf16x8*)(lds + PG8_SA(b, h) + aoff + m * 2048 + k * 1024); } } while (0)
#define PG8_LDB(dst, b, h) do { if constexpr (F8) { _Pragma("unroll") for (int n = 0; n < 2; ++n) dst##x[n] = __builtin_shufflevector(*(const PG8_LAS bf16x8*)(lds + PG8_SB(b, h) + boff + n * 2048), *(const PG8_LAS bf16x8*)(lds + PG8_SB(b, h) + boff + n * 2048 + 1024), 0, 1, 2, 3, 4, 5, 6, 7, 8, 9, 10, 11, 12, 13, 14, 15); } \
        else { _Pragma("unroll") for (int n = 0; n < 2; ++n) _Pragma("unroll") for (int k = 0; k < 2; ++k) dst[n][k] = *(const PG8_LAS bf16x8*)(lds + PG8_SB(b, h) + boff + n * 2048 + k * 1024); } } while (0)
#define PG8_MMA(ai, bj, At, Bt) do { __builtin_amdgcn_s_setprio(1); \
        if constexpr (F8) { _Pragma("unroll") for (int m = 0; m < 4; ++m) _Pragma("unroll") for (int n = 0; n < 2; ++n) \
            acc[ai][bj][m][n] = __builtin_amdgcn_mfma_scale_f32_16x16x128_f8f6f4(__builtin_bit_cast(i32x8, Bt##x[n]), __builtin_bit_cast(i32x8, At##x[m]), acc[ai][bj][m][n], 0, 0, 0, F8SCALE, 0, F8SCALE); } \
        else _Pragma("unroll") for (int m = 0; m < 4; ++m) _Pragma("unroll") for (int n = 0; n < 2; ++n) _Pragma("unroll") for (int k = 0; k < 2; ++k) { \
        if constexpr (I8) acc[ai][bj][m][n] = __builtin_amdgcn_mfma_i32_16x16x64_i8(__builtin_bit_cast(i32x4, Bt[n][k]), __builtin_bit_cast(i32x4, At[m][k]), acc[ai][bj][m][n], 0, 0, 0); \
        else acc[ai][bj][m][n] = __builtin_amdgcn_mfma_f32_16x16x32_bf16(Bt[n][k], At[m][k], acc[ai][bj][m][n], 0, 0, 0); } __builtin_amdgcn_s_setprio(0); } while (0)
#define PG8_WAIT_V(n) asm volatile("s_waitcnt vmcnt(" #n ")" ::: "memory")
#define PG8_WAIT_L(n) asm volatile("s_waitcnt lgkmcnt(" #n ")" ::: "memory")
#define PG8_BAR __builtin_amdgcn_s_barrier()
#define PG8_SCHED __builtin_amdgcn_sched_barrier(0)
#define PG8_AOFF(dst, u) do { _Pragma("unroll") for (int _h = 0; _h < 2; ++_h) _Pragma("unroll") for (int _i = 0; _i < 2; ++_i) { \
        int _row = (u).pm * BM + _h * HALF + R0 + 64 * _i; if (GATHER) { const int _t = S.rowmap[_row]; _row = _t < 0 ? 0 : (_t >> 1); } \
        dst[_h][_i] = (unsigned)_row * (unsigned)K + (unsigned)C0; } } while (0)
    Unit cur, nxt; int ui = 0;
    if (!S.next(0, cur)) return;
    cur.pm = __builtin_amdgcn_readfirstlane(cur.pm); cur.pn = __builtin_amdgcn_readfirstlane(cur.pn); cur.pb = __builtin_amdgcn_readfirstlane(cur.pb);
    typedef typename AccT<I8>::type acc_t;
    acc_t acc[2][2][4][2];
#pragma unroll
    for (int a = 0; a < 2; ++a)
#pragma unroll
        for (int b = 0; b < 2; ++b)
#pragma unroll
            for (int m = 0; m < 4; ++m)
#pragma unroll
                for (int n = 0; n < 2; ++n) acc[a][b][m][n] = (acc_t){0, 0, 0, 0};
    bf16x8 At[4][2], B0[2][2], B1[2][2]; bf16x16 Atx[4], B0x[2], B1x[2];
    unsigned oA[2][2]; PG8_AOFF(oA, cur);
    PG8_LAS unsigned char* const eslot = lds + EPI_SLOT_OFF + wid * 768;
    if constexpr (I8 && Epi::RAW) E.pre_dma(cur, wid, wr, wc, lane, eslot);
    const char* Ab = (const char*)g.A; const char* cB = (const char*)g.Bt + (size_t)cur.pb * tstep;
    PG8_STAGE(PG8_SB(0, 0), cB, voffB); PG8_STAGE(PG8_SB(0, 1), cB + hstep, voffB); PG8_STAGE(PG8_SA(0, 0), Ab, oA[0]); PG8_STAGE(PG8_SA(0, 1), Ab, oA[1]);
    if (wr == 1) PG8_BAR;
    PG8_WAIT_V(2); PG8_BAR;
    PG8_STAGE(PG8_SB(1, 0), cB + kstep, voffB); PG8_STAGE(PG8_SA(1, 0), Ab + kstep, oA[0]); PG8_STAGE(PG8_SB(1, 1), cB + hstep + kstep, voffB);
    PG8_WAIT_V(6); PG8_BAR;
    for (;;) {
        const bool has_next = __builtin_amdgcn_readfirstlane((int)S.next(ui + 1, nxt)) != 0;
        nxt.pm = __builtin_amdgcn_readfirstlane(nxt.pm); nxt.pn = __builtin_amdgcn_readfirstlane(nxt.pn); nxt.pb = __builtin_amdgcn_readfirstlane(nxt.pb);
        const char* nB = has_next ? (const char*)g.Bt + (size_t)nxt.pb * tstep : cB;
        for (int t = 0; t < nt; t += 2) {
            const bool last = (t == nt - 2);
            const bool sw = last && has_next;
            const char* a1 = Ab + (size_t)(t + 1) * kstep;
            const char* a2 = last ? Ab : Ab + (size_t)(t + 2) * kstep; const char* b2 = last ? nB : cB + (size_t)(t + 2) * kstep;
            const char* a3 = a2 + kstep; const char* b3 = b2 + kstep;
            unsigned nO[2][2];
            if (sw) { PG8_AOFF(nO, nxt); }
            PG8_LDB(B0, 0, 0); PG8_LDB(B1, 0, 1); PG8_SCHED; PG8_LDA(At, 0, 0); PG8_STAGE(PG8_SA(1, 1), a1, oA[1]);
            PG8_WAIT_V(8); PG8_WAIT_L(0); PG8_BAR; PG8_MMA(0, 0, At, B0); PG8_MMA(0, 1, At, B1); PG8_BAR; PG8_SCHED;
            if (sw) { oA[0][0] = nO[0][0]; oA[0][1] = nO[0][1]; oA[1][0] = nO[1][0]; oA[1][1] = nO[1][1]; }
            PG8_LDA(At, 0, 1); PG8_STAGE(PG8_SB(0, 0), b2, voffB); PG8_STAGE(PG8_SB(0, 1), b2 + hstep, voffB); PG8_STAGE(PG8_SA(0, 0), a2, oA[0]);
            PG8_WAIT_V(8); PG8_WAIT_L(0); PG8_BAR; PG8_MMA(1, 0, At, B0); PG8_MMA(1, 1, At, B1); PG8_BAR; PG8_SCHED;
            PG8_LDB(B0, 1, 0); PG8_LDB(B1, 1, 1); PG8_SCHED; PG8_LDA(At, 1, 0); PG8_STAGE(PG8_SA(0, 1), a2, oA[1]);
            PG8_WAIT_V(8); PG8_WAIT_L(0); PG8_BAR; PG8_MMA(0, 0, At, B0); PG8_MMA(0, 1, At, B1); PG8_BAR; PG8_SCHED;
            PG8_LDA(At, 1, 1); PG8_STAGE(PG8_SB(1, 0), b3, voffB); PG8_STAGE(PG8_SB(1, 1), b3 + hstep, voffB); PG8_STAGE(PG8_SA(1, 0), a3, oA[0]);
            PG8_WAIT_V(8); PG8_WAIT_L(0); PG8_BAR; PG8_MMA(1, 0, At, B0); PG8_MMA(1, 1, At, B1); PG8_BAR; PG8_SCHED;
        }
        if constexpr (ALIGN_EPI) { if (wr == 0) PG8_BAR; }
        if constexpr (F8) {
            { const int le_ = fresh_lane(); E(acc, cur, wr, wc, le_ & 15, le_ >> 4); }
        } else if constexpr (I8) {
            static_assert(!I8 || Epi::PERM, "int8 dequant assumes the PERM column layout");
            if constexpr (Epi::RAW) {
                float csa[2][4]; f32x4 csw[2][2];
                E.pre_read(eslot, fr, fq, csa, csw); PG8_WAIT_L(0);
                { Unit pu; pu.pm = has_next ? nxt.pm : cur.pm; pu.pn = has_next ? nxt.pn : cur.pn; pu.pb = has_next ? nxt.pb : cur.pb; E.pre_dma(pu, wid, wr, wc, lane, eslot); }
                E.raw(acc, cur, wr, wc, fr, fq, csa, csw); } else {
            f32x4 accf[2][2][4][2]; f32x4 swv[2][2];
            const float* swp = E.sw + (size_t)cur.pb * BM + wc * 32 + 8 * fq;
#pragma unroll
            for (int bj = 0; bj < 2; ++bj)
#pragma unroll
                for (int n = 0; n < 2; ++n) swv[bj][n] = *(const f32x4*)(swp + bj * HALF + 4 * n);
#pragma unroll
            for (int ai = 0; ai < 2; ++ai)
#pragma unroll
                for (int m = 0; m < 4; ++m) { int row = cur.pm * BM + ai * HALF + wr * 64 + m * 16 + fr; if (GATHER) { const int t_ = S.rowmap[row]; row = t_ < 0 ? 0 : (t_ >> 1); } const float sa = E.sa[row];
#pragma unroll
                    for (int bj = 0; bj < 2; ++bj)
#pragma unroll
                        for (int n = 0; n < 2; ++n)
#pragma unroll
                            for (int e = 0; e < 4; ++e) accf[ai][bj][m][n][e] = (float)acc[ai][bj][m][n][e] * (sa * swv[bj][n][e]); }
            E(accf, cur, wr, wc, fr, fq); }
        } else {
            E(acc, cur, wr, wc, fr, fq);
        }
        if (!has_next) break;
#pragma unroll
        for (int a = 0; a < 2; ++a)
#pragma unroll
            for (int b = 0; b < 2; ++b)
#pragma unroll
                for (int m = 0; m < 4; ++m)
#pragma unroll
                    for (int n = 0; n < 2; ++n) acc[a][b][m][n] = (acc_t){0, 0, 0, 0};
        cur = nxt; cB = nB; ++ui;
        if constexpr (ALIGN_EPI) { if (wr == 1) PG8_BAR; }
    }
    PG8_WAIT_V(0);
    if constexpr (!ALIGN_EPI) { if (wr == 0) PG8_BAR; }
    PG8_BAR;
#undef PG8_SA
#undef PG8_SB
#undef PG8_STAGE
#undef PG8_LDA
#undef PG8_LDB
#undef PG8_MMA
#undef PG8_WAIT_V
#undef PG8_WAIT_L
#undef PG8_BAR
#undef PG8_SCHED
#undef PG8_AOFF
}

__device__ __forceinline__ float silu_f(float x) { return x * __builtin_amdgcn_rcpf(1.0f + __builtin_amdgcn_exp2f(-1.44269504f * x)); }
__device__ __forceinline__ float gelu_f(float x) { const float t = x * x; const float a = x * (2.30220819f + 0.10294324f * t); return x * __builtin_amdgcn_rcpf(1.0f + __builtin_amdgcn_exp2f(-a)); }

struct EpiSguIn {
    static constexpr bool PERM = true; static constexpr bool RAW = false;
    bf16_t* U; bf16_t* V; float2* vstat; const float* sa; const float* sw;
    __device__ __forceinline__ void operator()(const f32x4 (&acc)[2][2][4][2], const Unit& u, int wr, int wc, int fr, int fq) const {
        const int row0 = u.pm * BM + wr * 64 + fr; const bool isV = u.pn >= 8; bf16_t* base = isV ? V : U;
        const int col0 = (u.pn & 7) * BM + wc * 32 + 8 * fq;
#pragma unroll
        for (int ai = 0; ai < 2; ++ai)
#pragma unroll
            for (int m = 0; m < 4; ++m) { const int row = row0 + ai * HALF + m * 16; bf16_t* rowp = base + (size_t)row * SGW + col0; float s = 0.f, q = 0.f;
#pragma unroll
                for (int bj = 0; bj < 2; ++bj) { f32x4 v0 = acc[ai][bj][m][0], v1 = acc[ai][bj][m][1];
                    if (isV) {
#pragma unroll
                        for (int e = 0; e < 4; ++e) { v0[e] = gelu_f(v0[e]); v1[e] = gelu_f(v1[e]); s += v0[e] + v1[e]; q += v0[e] * v0[e] + v1[e] * v1[e]; } }
                    u32x4 w; w.x = cvt_pk_bf16(v0[0], v0[1]); w.y = cvt_pk_bf16(v0[2], v0[3]); w.z = cvt_pk_bf16(v1[0], v1[1]); w.w = cvt_pk_bf16(v1[2], v1[3]);
                    *(u32x4*)(rowp + bj * HALF) = w; }
                if (isV) { const int ln = fq * 16 + fr; s += shx(s, 16, ln); s += shx(s, 32, ln); q += shx(q, 16, ln); q += shx(q, 32, ln);
                    if (fq == 0) vstat[(size_t)row * 32 + (u.pn - 8) * 4 + wc] = make_float2(s, q); } }
    }
};
struct EpiDelta {
    static constexpr bool PERM = true; static constexpr bool RAW = false;
    bf16_t* out; const float* gate; const float* sa; const float* sw;
    __device__ __forceinline__ void operator()(const f32x4 (&acc)[2][2][4][2], const Unit& u, int wr, int wc, int fr, int fq) const {
        const int row0 = u.pm * BM + wr * 64 + fr, col0 = u.pn * BM + wc * 32 + 8 * fq; const int b = (u.pm * BM) / SEQ;
        f32x4 gv[2][2];
#pragma unroll
        for (int bj = 0; bj < 2; ++bj)
#pragma unroll
            for (int n = 0; n < 2; ++n) gv[bj][n] = *(const f32x4*)(gate + (size_t)b * MODW + col0 + bj * HALF + 4 * n);
#pragma unroll
        for (int ai = 0; ai < 2; ++ai)
#pragma unroll
            for (int m = 0; m < 4; ++m) { bf16_t* rowp = out + (size_t)(row0 + ai * HALF + m * 16) * D + col0;
#pragma unroll
                for (int bj = 0; bj < 2; ++bj) { const f32x4 a0 = acc[ai][bj][m][0] * gv[bj][0], a1 = acc[ai][bj][m][1] * gv[bj][1];
                    u32x4 o; o.x = cvt_pk_bf16(a0[0], a0[1]); o.y = cvt_pk_bf16(a0[2], a0[3]); o.z = cvt_pk_bf16(a1[0], a1[1]); o.w = cvt_pk_bf16(a1[2], a1[3]); *(u32x4*)(rowp + bj * HALF) = o; } }
    }
};
struct EpiDeltaF8 {
    static constexpr bool PERM = true; static constexpr bool RAW = false;
    bf16_t* out; const float* gate; const float* sw; float f8s;
    __device__ __forceinline__ void operator()(const f32x4 (&acc)[2][2][4][2], const Unit& u, int wr, int wc, int fr, int fq) const {
        const int row0 = u.pm * BM + wr * 64 + fr, col0 = u.pn * BM + wc * 32 + 8 * fq; const int b = (u.pm * BM) / SEQ;
#pragma unroll
        for (int bj = 0; bj < 2; ++bj) { const float* gp = gate + (size_t)b * MODW + col0 + bj * HALF; const float* sp = sw + (size_t)u.pb * BM + wc * 32 + 8 * fq + bj * HALF;
            const f32x4 g0 = *(const f32x4*)gp * *(const f32x4*)sp * f8s, g1 = *(const f32x4*)(gp + 4) * *(const f32x4*)(sp + 4) * f8s;
#pragma unroll
            for (int ai = 0; ai < 2; ++ai)
#pragma unroll
                for (int m = 0; m < 4; ++m) { bf16_t* rowp = out + (size_t)(row0 + ai * HALF + m * 16) * D + col0 + bj * HALF; const f32x4 a0 = acc[ai][bj][m][0] * g0, a1 = acc[ai][bj][m][1] * g1;
                    u32x4 o; o.x = cvt_pk_bf16(a0[0], a0[1]); o.y = cvt_pk_bf16(a0[2], a0[3]); o.z = cvt_pk_bf16(a1[0], a1[1]); o.w = cvt_pk_bf16(a1[2], a1[3]); *(u32x4*)rowp = o; } }
    }
};
struct EpiSwiglu {
    static constexpr bool PERM = true; static constexpr bool RAW = false;
    bf16_t* O; int ldc; const float* sa; const float* sw;
    __device__ __forceinline__ void operator()(const f32x4 (&acc)[2][2][4][2], const Unit& u, int wr, int wc, int fr, int fq) const {
        const int row0 = u.pm * BM + wr * 64 + fr, col0 = u.pn * HALF + wc * 32 + 8 * fq;
#pragma unroll
        for (int ai = 0; ai < 2; ++ai)
#pragma unroll
            for (int m = 0; m < 4; ++m) { bf16_t* rowp = O + (size_t)(row0 + ai * HALF + m * 16) * ldc + col0;
                f32x4 v0, v1;
#pragma unroll
                for (int e = 0; e < 4; ++e) { v0[e] = silu_f(acc[ai][0][m][0][e]) * acc[ai][1][m][0][e]; v1[e] = silu_f(acc[ai][0][m][1][e]) * acc[ai][1][m][1][e]; }
                u32x4 w; w.x = cvt_pk_bf16(v0[0], v0[1]); w.y = cvt_pk_bf16(v0[2], v0[3]); w.z = cvt_pk_bf16(v1[0], v1[1]); w.w = cvt_pk_bf16(v1[2], v1[3]);
                *(u32x4*)rowp = w; }
    }
};
constexpr float ACT_F8 = 4.0f;
__device__ __forceinline__ unsigned pk4_fp8(float a, float b, float c, float d) {
    a = __builtin_fminf(__builtin_fmaxf(a, -448.f), 448.f); b = __builtin_fminf(__builtin_fmaxf(b, -448.f), 448.f); c = __builtin_fminf(__builtin_fmaxf(c, -448.f), 448.f); d = __builtin_fminf(__builtin_fmaxf(d, -448.f), 448.f);
    unsigned w = 0u; w = __builtin_amdgcn_cvt_pk_fp8_f32(a, b, w, false); w = __builtin_amdgcn_cvt_pk_fp8_f32(c, d, w, true); return w; }
struct EpiSwigluF8 {
    static constexpr bool PERM = true; static constexpr bool RAW = true;
    unsigned char* O; int ldc; const float* sa; const float* sw;
    __device__ __forceinline__ void pre_dma(const Unit& u, int wid, int wr, int wc, int lane, PG8_LAS unsigned char* slot) const {
        const float* sap = sa + u.pm * BM + wr * 64 + lane; const float* swp = sw + (size_t)u.pb * BM + wc * 32 + (lane & 31) + (lane >> 5) * HALF;
        __builtin_amdgcn_global_load_lds((const unsigned*)sap, (PG8_LAS unsigned*)slot, 4, 0, 0);
        __builtin_amdgcn_global_load_lds((const unsigned*)(sap + HALF), (PG8_LAS unsigned*)(slot + 256), 4, 0, 0);
        __builtin_amdgcn_global_load_lds((const unsigned*)swp, (PG8_LAS unsigned*)(slot + 512), 4, 0, 0);
        (void)wid;
    }
    __device__ __forceinline__ void pre_read(PG8_LAS unsigned char* slot, int fr, int fq, float (&psa)[2][4], f32x4 (&psw)[2][2]) const {
        const PG8_LAS float* rp = (const PG8_LAS float*)slot;
#pragma unroll
        for (int ai = 0; ai < 2; ++ai)
#pragma unroll
            for (int m = 0; m < 4; ++m) psa[ai][m] = rp[ai * 64 + m * 16 + fr];
#pragma unroll
        for (int n = 0; n < 2; ++n) { psw[0][n] = *(const PG8_LAS f32x4*)(rp + 128 + 8 * fq + 4 * n); psw[1][n] = *(const PG8_LAS f32x4*)(rp + 160 + 8 * fq + 4 * n); }
    }
    __device__ __forceinline__ void raw(const i32x4 (&acc)[2][2][4][2], const Unit& u, int wr, int wc, int fr, int fq, const float (&sav)[2][4], const f32x4 (&swv)[2][2]) const {
        const int row0 = u.pm * BM + wr * 64 + fr, col0 = u.pn * HALF + wc * 32 + 8 * fq;
        f32x4 cg[2], cw[2];
#pragma unroll
        for (int n = 0; n < 2; ++n) { const f32x4 sg = swv[0][n], su = swv[1][n];
#pragma unroll
            for (int e = 0; e < 4; ++e) { cg[n][e] = -1.44269504f * sg[e]; cw[n][e] = sg[e] * su[e] * ACT_F8; } }
#pragma unroll
        for (int ai = 0; ai < 2; ++ai)
#pragma unroll
            for (int m = 0; m < 4; ++m) { const int row = row0 + ai * HALF + m * 16;
                const float sa_ = sav[ai][m]; unsigned char* rowp = O + (size_t)row * ldc + col0;
                f32x4 v[2];
#pragma unroll
                for (int n = 0; n < 2; ++n)
#pragma unroll
                    for (int e = 0; e < 4; ++e) { const float gs = (float)acc[ai][0][m][n][e] * sa_; const float uf = (float)acc[ai][1][m][n][e];
                        const float r = __builtin_amdgcn_rcpf(1.0f + __builtin_amdgcn_exp2f(gs * cg[n][e]));
                        v[n][e] = (gs * uf) * (cw[n][e] * sa_) * r; }
                u32x2 w; w.x = pk4_fp8(v[0][0], v[0][1], v[0][2], v[0][3]); w.y = pk4_fp8(v[1][0], v[1][1], v[1][2], v[1][3]);
                *(u32x2*)rowp = w; }
    }
    __device__ __forceinline__ void operator()(const f32x4 (&acc)[2][2][4][2], const Unit& u, int wr, int wc, int fr, int fq) const {
        const int row0 = u.pm * BM + wr * 64 + fr, col0 = u.pn * HALF + wc * 32 + 8 * fq;
#pragma unroll
        for (int ai = 0; ai < 2; ++ai)
#pragma unroll
            for (int m = 0; m < 4; ++m) { unsigned char* rowp = O + (size_t)(row0 + ai * HALF + m * 16) * ldc + col0;
                f32x4 v0, v1;
#pragma unroll
                for (int e = 0; e < 4; ++e) { v0[e] = silu_f(acc[ai][0][m][0][e]) * acc[ai][1][m][0][e] * ACT_F8; v1[e] = silu_f(acc[ai][0][m][1][e]) * acc[ai][1][m][1][e] * ACT_F8; }
                u32x2 w; w.x = pk4_fp8(v0[0], v0[1], v0[2], v0[3]); w.y = pk4_fp8(v1[0], v1[1], v1[2], v1[3]);
                *(u32x2*)rowp = w; }
    }
};
struct EpiRetIn {
    static constexpr bool PERM = true; static constexpr bool RAW = false;
    bf16_t *Q, *Kb, *V, *Gs; const int* pos; const float* sa; const float* sw;
    __device__ __forceinline__ void operator()(const f32x4 (&acc)[2][2][4][2], const Unit& u, int wr, int wc, int fr, int fq) const {
        const int row0 = u.pm * BM + wr * 64 + fr; const int pn = u.pn;
        if (pn < 8) {
            bf16_t* base = (pn < 4 ? Q : Kb) + (pn & 3) * RDK + wc * 32 + 8 * fq;
            const float lg2 = __builtin_amdgcn_logf(1.0f - __builtin_amdgcn_exp2f(-5.0f - (float)(pn & 3))) * (pn < 4 ? 1.0f : -1.0f); const float sc0 = pn < 4 ? 1.0f : 0.0625f;
            float invf[2][4];
#pragma unroll
            for (int n = 0; n < 2; ++n)
#pragma unroll
                for (int e = 0; e < 4; ++e) invf[n][e] = __builtin_amdgcn_exp2f(-(float)(32 * wc + 8 * fq + 4 * n + e) * 0.10381025296f) * 0.15915494309f;
            int posv[2][4];
#pragma unroll
            for (int ai = 0; ai < 2; ++ai)
#pragma unroll
                for (int m = 0; m < 4; ++m) posv[ai][m] = pos[row0 + ai * HALF + m * 16];
#pragma unroll
            for (int ai = 0; ai < 2; ++ai)
#pragma unroll
                for (int m = 0; m < 4; ++m) { const int row = row0 + ai * HALF + m * 16; const float p = (float)posv[ai][m]; bf16_t* rowp = base + (size_t)row * D; const float scale = sc0 * __builtin_amdgcn_exp2f((float)(row & 127) * lg2);
                    float o1[2][4], o2[2][4];
#pragma unroll
                    for (int n = 0; n < 2; ++n)
#pragma unroll
                        for (int e = 0; e < 4; ++e) { float r = p * invf[n][e]; r = __builtin_amdgcn_fractf(r); const float sn = __builtin_amdgcn_sinf(r), cs = __builtin_amdgcn_cosf(r);
                            const float t1 = acc[ai][0][m][n][e], t2 = acc[ai][1][m][n][e]; o1[n][e] = (t1 * cs - t2 * sn) * scale; o2[n][e] = (t2 * cs + t1 * sn) * scale; }
                    u32x4 w1, w2; w1.x = cvt_pk_bf16(o1[0][0], o1[0][1]); w1.y = cvt_pk_bf16(o1[0][2], o1[0][3]); w1.z = cvt_pk_bf16(o1[1][0], o1[1][1]); w1.w = cvt_pk_bf16(o1[1][2], o1[1][3]);
                    w2.x = cvt_pk_bf16(o2[0][0], o2[0][1]); w2.y = cvt_pk_bf16(o2[0][2], o2[0][3]); w2.z = cvt_pk_bf16(o2[1][0], o2[1][1]); w2.w = cvt_pk_bf16(o2[1][2], o2[1][3]);
                    *(u32x4*)rowp = w1; *(u32x4*)(rowp + HALF) = w2; }
        } else {
            const bool isG = pn >= 16; bf16_t* base = (isG ? Gs : V) + ((pn - 8) & 7) * BM + wc * 32 + 8 * fq;
#pragma unroll
            for (int ai = 0; ai < 2; ++ai)
#pragma unroll
                for (int m = 0; m < 4; ++m) { bf16_t* rowp = base + (size_t)(row0 + ai * HALF + m * 16) * (RH * RDV);
#pragma unroll
                    for (int bj = 0; bj < 2; ++bj) { f32x4 v0 = acc[ai][bj][m][0], v1 = acc[ai][bj][m][1];
                        u32x4 w; w.x = cvt_pk_bf16(v0[0], v0[1]); w.y = cvt_pk_bf16(v0[2], v0[3]); w.z = cvt_pk_bf16(v1[0], v1[1]); w.w = cvt_pk_bf16(v1[2], v1[3]);
                        *(u32x4*)(rowp + bj * HALF) = w; } }
        }
    }
};
struct EpiMoeDown {
    static constexpr bool PERM = true; static constexpr bool RAW = false;
    bf16_t* P0; long long dP;     const int* idx; const float* gw; const float* sw; float f8s;
    __device__ __forceinline__ void operator()(const f32x4 (&acc)[2][2][4][2], const Unit& u, int wr, int wc, int fr, int fq) const {
        const int row0 = u.pm * BM + wr * 64 + fr, col0 = u.pn * BM + wc * 32 + 8 * fq;
        int vv[2][4]; float ww[2][4];
#pragma unroll
        for (int ai = 0; ai < 2; ++ai)
#pragma unroll
            for (int m = 0; m < 4; ++m) { const int r = row0 + ai * HALF + m * 16; vv[ai][m] = idx[r]; ww[ai][m] = gw[r]; }
        f32x4 sc[2][2];
#pragma unroll
        for (int bj = 0; bj < 2; ++bj) { const float* sp = sw + (size_t)u.pb * BM + wc * 32 + 8 * fq + bj * HALF; sc[bj][0] = *(const f32x4*)sp * f8s; sc[bj][1] = *(const f32x4*)(sp + 4) * f8s; }
#pragma unroll
        for (int ai = 0; ai < 2; ++ai)
#pragma unroll
            for (int m = 0; m < 4; ++m) { const int v = vv[ai][m];
                if (v >= 0) { const int tok = v >> 1; const float w = ww[ai][m]; bf16_t* xp = P0 + (long long)(v & 1) * dP + (size_t)tok * D + col0;
#pragma unroll
                    for (int bj = 0; bj < 2; ++bj) { const f32x4 a0 = acc[ai][bj][m][0] * sc[bj][0] * w, a1 = acc[ai][bj][m][1] * sc[bj][1] * w;
                        u32x4 o; o.x = cvt_pk_bf16(a0[0], a0[1]); o.y = cvt_pk_bf16(a0[2], a0[3]); o.z = cvt_pk_bf16(a1[0], a1[1]); o.w = cvt_pk_bf16(a1[2], a1[3]); *(u32x4*)(xp + bj * HALF) = o; } } }
    }
};
}

constexpr size_t MiB = 1u << 20;
constexpr size_t WS_CTL = 0, CTL_ZERO_BYTES = 1 * MiB;
constexpr size_t WS_MOD = 1 * MiB;
constexpr size_t WS_VSTAT = 2 * MiB;
constexpr size_t WS_RSTAT = 10 * MiB;
constexpr size_t WS_X16 = 16 * MiB;
constexpr size_t WS_W_SGU_IN = 80 * MiB, WS_W_SGU_OUT = 84 * MiB, WS_W_FFN_GU = 88 * MiB, WS_W_FFN_DN = 94 * MiB, WS_W_RET_IN = 100 * MiB, WS_W_RET_OUT = 106 * MiB;
constexpr size_t WS_W_MOE_GU = 110 * MiB, WS_W_MOE_DN = 154 * MiB;
constexpr size_t WS_XN = 198 * MiB;
constexpr size_t WS_P0 = WS_XN;
constexpr size_t WS_R1 = 262 * MiB;
constexpr size_t WS_U = WS_R1, WS_V = WS_R1 + 128 * MiB;
constexpr size_t WS_DELTA = WS_R1 + 256 * MiB;
constexpr size_t WS_ACT = WS_R1;
constexpr size_t WS_Q = WS_R1, WS_K = WS_R1 + 64 * MiB, WS_RV = WS_R1 + 128 * MiB, WS_G = WS_R1 + 256 * MiB;
constexpr size_t WS_P1 = WS_R1 + 363 * MiB;
constexpr size_t WS_SMALL = WS_P1 + 64 * MiB;
constexpr size_t WS_ROUTE = WS_SMALL;
constexpr size_t WS_RTAB = WS_SMALL + 768 * 1024;
constexpr size_t WS_LIST = WS_SMALL + 1 * MiB;
constexpr size_t WS_SA = WS_SMALL + 2 * MiB;
constexpr size_t WS_SW = WS_SMALL + 3 * MiB;
constexpr int SW_SGU = 0, SW_FFN = 2 * SGW, SW_RET = SW_FFN + 2 * FF, SW_MOE = SW_RET + RET_IN, SW_RO = SW_MOE + NE * 2 * FF, SW_MD = SW_RO + D, SW_FD = SW_MD + NE * D, NSW = SW_FD + D;
constexpr size_t CTL_COLMAX = 512 * 1024;
constexpr size_t LIST_IDX = 0, LIST_GW = (size_t)LCAP * 4, LIST_TE = LIST_GW + (size_t)LCAP * 4, LIST_NT = LIST_TE + (size_t)LTILES * 4, LIST_SAL = LIST_NT + 64;
constexpr size_t WS_END = WS_SMALL + 4 * MiB;
static_assert(WS_W_FFN_DN + (size_t)D * FF * 2 <= WS_W_RET_IN && WS_W_FFN_GU + (size_t)2 * FF * D <= WS_W_FFN_DN && WS_W_RET_IN + (size_t)RET_IN * D <= WS_W_RET_OUT && WS_W_MOE_GU + (size_t)NE * 2 * FF * D <= WS_W_MOE_DN && WS_W_MOE_DN + (size_t)NE * FF * D * 2 <= WS_XN, "weight map");
static_assert(WS_LIST + LIST_SAL + (size_t)LCAP * 4 <= WS_SA && WS_SW + (size_t)NSW * 4 <= WS_END && (size_t)LCAP * FF * 2 <= 363 * MiB && WS_X16 + (size_t)M * D * 2 <= WS_W_SGU_IN && WS_END <= 700 * MiB, "map");
constexpr int CW_BAR = 4096;

constexpr int RING_BYTES = 131072, LDSCTL_OFF = RING_BYTES, MISC_OFF = LDSCTL_OFF + 320, EXTRA_OFF = RING_BYTES + 1024, LDS_BYTES = 147456;

typedef float f32x4 __attribute__((ext_vector_type(4)));
typedef unsigned v4u __attribute__((ext_vector_type(4)));
typedef unsigned v2u __attribute__((ext_vector_type(2)));
#define LDS_WAIT() asm volatile("s_waitcnt lgkmcnt(0)" ::: "memory")
__device__ __forceinline__ unsigned f2bf(float f) { unsigned u = __builtin_bit_cast(unsigned, f); return (u + 0x7fffu + ((u >> 16) & 1u)) >> 16; }
__device__ __forceinline__ unsigned pk2(float lo, float hi) { return f2bf(lo) | (f2bf(hi) << 16); }
__device__ __forceinline__ float u2f(unsigned w) { return __builtin_bit_cast(float, w); }
__device__ __forceinline__ float bflo(unsigned w) { return __builtin_bit_cast(float, w << 16); }
__device__ __forceinline__ float bfhi(unsigned w) { return __builtin_bit_cast(float, w & 0xffff0000u); }
__device__ __forceinline__ float bf2f(bf16 b) { return __builtin_bit_cast(float, (unsigned)b << 16); }
template <int CTRL> __device__ __forceinline__ float dpp_f(float v) { return __builtin_bit_cast(float, __builtin_amdgcn_update_dpp(0, __builtin_bit_cast(int, v), CTRL, 0xf, 0xf, true)); }
__device__ __forceinline__ float rdl_f(float v, int l) { return __builtin_bit_cast(float, __builtin_amdgcn_readlane(__builtin_bit_cast(int, v), l)); }
__device__ __forceinline__ float wave_sum(float v, int lane) {
    (void)lane;
    v += dpp_f<0xB1>(v); v += dpp_f<0x4E>(v); v += dpp_f<0x141>(v); v += dpp_f<0x140>(v);
    return (rdl_f(v, 0) + rdl_f(v, 16)) + (rdl_f(v, 32) + rdl_f(v, 48));
}

#define XB_TMO      128
#define XB_XCNT(j)  (256  + 64 * (j))
#define XB_XSUB(j)  (1280 + 64 * (j))
#define XB_XGEN(j)  (2304 + 64 * (j))
#define XB_TOP      3328
#define XB_TOPGEN   3392
#define XCD_BAR_WORDS 3456
#define XB_SPIN_CAP (1u << 18)
__device__ __forceinline__ unsigned xb_ld(unsigned* p)              { return __hip_atomic_load(p, __ATOMIC_RELAXED, __HIP_MEMORY_SCOPE_AGENT); }
__device__ __forceinline__ unsigned xb_add(unsigned* p, unsigned v) { return __hip_atomic_fetch_add(p, v, __ATOMIC_RELAXED, __HIP_MEMORY_SCOPE_AGENT); }
__device__ __forceinline__ unsigned xb_xcc_id() { return (unsigned)__builtin_amdgcn_s_getreg((3 << 11) | 20) & 0xFu; }
#define XB_SPIN(cond, bar) do { unsigned _sp = 0; while (cond) { __builtin_amdgcn_s_sleep(1); \
    if ((++_sp & 255u) == 0u) { if (xb_ld(&(bar)[XB_TMO])) break; if (_sp > XB_SPIN_CAP) { atomicAdd(&(bar)[XB_TMO], 1u); break; } } } } while (0)
struct XcdBarrier { unsigned* bar; unsigned x; volatile LAS unsigned* st; };
__device__ __forceinline__ XcdBarrier xcd_barrier_post(unsigned* bar, volatile LAS unsigned* st) {
    XcdBarrier b; b.bar = bar; b.x = xb_xcc_id(); b.st = st;
    if (threadIdx.x == 0) st[2] = xb_add(&bar[XB_XCNT(b.x)], 1u);
    return b;
}
__device__ __forceinline__ void xcd_barrier_complete(unsigned* bar, unsigned x, unsigned& nloc, unsigned& nx) {
    const unsigned G = gridDim.x * gridDim.y * gridDim.z;
    unsigned sum, cnt, mine, sp = 0u;
    for (;;) {
        sum = 0u; cnt = 0u; mine = 0u;
#pragma unroll
        for (unsigned j = 0; j < 16; ++j) { const unsigned c = xb_ld(&bar[XB_XCNT(j)]); sum += c; cnt += (c > 0u) ? 1u : 0u; mine = (j == x) ? c : mine; }
        if (sum == G) break;
        __builtin_amdgcn_s_sleep(1);
        if ((++sp & 255u) == 0u) { if (xb_ld(&bar[XB_TMO])) break; if (sp > XB_SPIN_CAP) { atomicAdd(&bar[XB_TMO], 1u); break; } }
    }
    nloc = mine > 0u ? mine : 1u; nx = cnt > 0u ? cnt : 1u;
}
__device__ __forceinline__ void xcd_barrier(const XcdBarrier& b) {
    asm volatile("s_waitcnt vmcnt(0)" ::: "memory");
    __syncthreads();
    if (threadIdx.x == 0) {
        unsigned* bar = b.bar;
        __builtin_amdgcn_s_waitcnt(0);
        unsigned nloc = b.st[0], nx = b.st[1];
        if (nloc == 0u) { xcd_barrier_complete(bar, b.x, nloc, nx); b.st[0] = nloc; b.st[1] = nx; }
        const unsigned old = xb_add(&bar[XB_XSUB(b.x)], 1u);
        const unsigned gen = old / nloc;
        if (old + 1u == (gen + 1u) * nloc) {
            __builtin_amdgcn_fence(__ATOMIC_RELEASE, "agent");
            asm volatile("s_waitcnt vmcnt(0)" ::: "memory");
            const unsigned og = xb_add(&bar[XB_TOP], 1u);
            const unsigned tg = og / nx;
            if (og + 1u == (tg + 1u) * nx) xb_add(&bar[XB_TOPGEN], 1u);
            else XB_SPIN(xb_ld(&bar[XB_TOPGEN]) == tg, bar);
            __builtin_amdgcn_fence(__ATOMIC_ACQUIRE, "agent");
            xb_add(&bar[XB_XGEN(b.x)], 1u);
            asm volatile("s_waitcnt vmcnt(0)" ::: "memory");
        } else {
            XB_SPIN(xb_ld(&bar[XB_XGEN(b.x)]) == gen, bar);
            __builtin_amdgcn_fence(__ATOMIC_ACQUIRE, "agent");
            asm volatile("s_waitcnt vmcnt(0)" ::: "memory");
        }
    }
    __syncthreads();
}

__device__ __forceinline__ void mod_phase(const float* c, const float* ada_w, const float* ada_b, float* MOD, LAS unsigned char* lds, int tid, int lane, int wave, int bid, int G) {
    LAS float* sc = (LAS float*)lds;
    LAS float* red = (LAS float*)(lds + 32768);
    for (int i = tid; i < NB * D; i += 512) { const float v = c[i]; sc[i] = v / (1.0f + __expf(-v)); }
    __syncthreads();
    constexpr int CPI = 48, NITEM = 2 * MODW / CPI;
    for (int it = bid; it < NITEM; it += G) {
        const int col = it * CPI + (lane < CPI ? lane : CPI - 1); const int l = col / MODW, cl = col % MODW;
        const float* w = ada_w + (size_t)l * D * MODW + (size_t)(wave * 128) * MODW + cl;
        float a[NB];
#pragma unroll
        for (int b = 0; b < NB; ++b) a[b] = 0.f;
#pragma unroll 8
        for (int k = 0; k < 128; ++k) { const float wv = w[(size_t)k * MODW];
#pragma unroll
            for (int b = 0; b < NB; ++b) a[b] += sc[b * D + wave * 128 + k] * wv; }
#pragma unroll
        for (int b = 0; b < NB; ++b) red[(wave * NB + b) * 64 + lane] = a[b];
        __syncthreads();
        { const int b = tid >> 6; float s = 0.f;
#pragma unroll
            for (int w8 = 0; w8 < 8; ++w8) s += red[(w8 * NB + b) * 64 + lane];
            if (lane < CPI) MOD[(size_t)(l * NB + b) * MODW + cl] = s + ada_b[l * MODW + cl]; }
        __syncthreads();
    }
}
template <int MODE>
__device__ __forceinline__ void cvt_item(const float* W, int K, int N, bf16* WT, LAS float* scr, int item, int lane) {
    const int nblk = N / 32, kb = item / nblk, nb = item % nblk, k0 = 64 * kb, n0 = 32 * nb;
    int drow0 = n0;
    if (MODE == 1) { const int half = n0 >= FF ? 1 : 0; const int j = n0 - half * FF; drow0 = (j >> 7) * 256 + half * 128 + (j & 127); }
#pragma unroll 8
    for (int i = 0; i < 32; ++i) { const int kk = 2 * i + (lane >> 5); scr[kk * 33 + (lane & 31)] = W[(size_t)(k0 + kk) * N + n0 + (lane & 31)]; }
    LDS_WAIT(); asm volatile("" ::: "memory");
    const int c = lane & 7;
#pragma unroll
    for (int j = 0; j < 4; ++j) { const int n = (lane >> 3) + 8 * j; const LAS float* s = scr + (8 * c) * 33 + n;
        v4u o; o.x = pk2(s[0 * 33], s[1 * 33]); o.y = pk2(s[2 * 33], s[3 * 33]); o.z = pk2(s[4 * 33], s[5 * 33]); o.w = pk2(s[6 * 33], s[7 * 33]);
        *(v4u*)(WT + (size_t)(drow0 + n) * K + k0 + 8 * c) = o; }
    LDS_WAIT(); asm volatile("" ::: "memory");
}
constexpr int AMK = 32;
template <int MODE>
__device__ __forceinline__ void amax_item(const float* W, int K, int N, unsigned* cmax, int item, int lane) {
    const int nblk = N / 256, kb = item / nblk, nb = item % nblk, k0 = AMK * kb, n0 = 256 * nb + 4 * lane;
    int drow0 = n0;
    if (MODE == 1) { const int half = n0 >= FF ? 1 : 0; const int j = n0 - half * FF; drow0 = (j >> 7) * 256 + half * 128 + (j & 127); }
    f32x4 mx = {0.f, 0.f, 0.f, 0.f};
    const float* wp = W + (size_t)k0 * N + n0;
#pragma unroll 8
    for (int i = 0; i < AMK; ++i) { const f32x4 v = *(const f32x4*)(wp + (size_t)i * N); mx[0] = fmaxf(mx[0], fabsf(v[0])); mx[1] = fmaxf(mx[1], fabsf(v[1])); mx[2] = fmaxf(mx[2], fabsf(v[2])); mx[3] = fmaxf(mx[3], fabsf(v[3])); }
#pragma unroll
    for (int e = 0; e < 4; ++e) atomicMax(cmax + drow0 + e, __builtin_bit_cast(unsigned, (float)mx[e]));
}
template <int MODE>
__device__ __forceinline__ void cvt8_item(const float* W, int K, int N, signed char* WT, const unsigned* cmax, float* sw, LAS float* scr, int item, int lane) {
    const int nblk = N / 32, kb = item / nblk, nb = item % nblk, k0 = 64 * kb, n0 = 32 * nb;
    int drow0 = n0;
    if (MODE == 1) { const int half = n0 >= FF ? 1 : 0; const int j = n0 - half * FF; drow0 = (j >> 7) * 256 + half * 128 + (j & 127); }
#pragma unroll 8
    for (int i = 0; i < 32; ++i) { const int kk = 2 * i + (lane >> 5); scr[kk * 33 + (lane & 31)] = W[(size_t)(k0 + kk) * N + n0 + (lane & 31)]; }
    LDS_WAIT(); asm volatile("" ::: "memory");
    const int c = lane & 7;
#pragma unroll
    for (int j = 0; j < 4; ++j) { const int n = (lane >> 3) + 8 * j; const LAS float* sp = scr + (8 * c) * 33 + n;
        const float am = u2f(cmax[drow0 + n]); const float inv = am > 0.f ? 127.0f / am : 0.f;
        unsigned w0 = 0u, w1 = 0u;
#pragma unroll
        for (int e = 0; e < 4; ++e) { const int q0 = (int)__builtin_rintf(sp[e * 33] * inv), q1 = (int)__builtin_rintf(sp[(4 + e) * 33] * inv); w0 |= ((unsigned)q0 & 0xffu) << (8 * e); w1 |= ((unsigned)q1 & 0xffu) << (8 * e); }
        v2u o; o.x = w0; o.y = w1; *(v2u*)(WT + (size_t)(drow0 + n) * K + k0 + 8 * c) = o;
        if (kb == 0 && c == 0) sw[drow0 + n] = am * (1.0f / 127.0f); }
    LDS_WAIT(); asm volatile("" ::: "memory");
}
__device__ __forceinline__ void cvtf8_item(const float* W, int K, int N, unsigned char* WT, const unsigned* cmax, float* sw, LAS float* scr, int item, int lane) {
    const int nblk = N / 32, kb = item / nblk, nb = item % nblk, k0 = 64 * kb, n0 = 32 * nb;
#pragma unroll 8
    for (int i = 0; i < 32; ++i) { const int kk = 2 * i + (lane >> 5); scr[kk * 33 + (lane & 31)] = W[(size_t)(k0 + kk) * N + n0 + (lane & 31)]; }
    LDS_WAIT(); asm volatile("" ::: "memory");
    const int c = lane & 7;
#pragma unroll
    for (int j = 0; j < 4; ++j) { const int n = (lane >> 3) + 8 * j; const LAS float* sp = scr + (8 * c) * 33 + n;
        const float am = u2f(cmax[n0 + n]); int ex = 0; if (am > 0.f) ex = 7 - ((int)((cmax[n0 + n] >> 23) & 0xffu) - 127);
        ex -= 1; const float sc = __builtin_ldexpf(1.0f, ex);
        v2u o; o.x = pg8::pk4_fp8(sp[0 * 33] * sc, sp[1 * 33] * sc, sp[2 * 33] * sc, sp[3 * 33] * sc); o.y = pg8::pk4_fp8(sp[4 * 33] * sc, sp[5 * 33] * sc, sp[6 * 33] * sc, sp[7 * 33] * sc);
        *(v2u*)(WT + (size_t)(n0 + n) * K + k0 + 8 * c) = o;
        if (kb == 0 && c == 0) sw[n0 + n] = __builtin_ldexpf(1.0f, -ex); }
    LDS_WAIT(); asm volatile("" ::: "memory");
}
template <int MODE, bool F8>
__device__ __forceinline__ void cvtq_tile(const float* W, int K, int N, unsigned char* WT, const unsigned* cmax, float* sw, LAS float* scr, int item, int tid) {
    const int nblk = N / 128, kb = item / nblk, nb = item % nblk, k0 = 128 * kb, n0 = 128 * nb;
    int drow0 = n0;
    if (MODE == 1) { const int half = n0 >= FF ? 1 : 0; const int j = n0 - half * FF; drow0 = (j >> 7) * 256 + half * 128; }
    const int lane = tid & 63, w = tid >> 6;
    { const float* wp = W + (size_t)(k0 + w * 16 + (lane >> 5)) * N + n0 + (lane & 31) * 4;
      f32x4 v[8];
#pragma unroll
      for (int i = 0; i < 8; ++i) v[i] = *(const f32x4*)(wp + (size_t)(2 * i) * N);
#pragma unroll
      for (int i = 0; i < 8; ++i) *(LAS f32x4*)(scr + (w * 16 + 2 * i + (lane >> 5)) * 132 + (lane & 31) * 4) = v[i]; }
    __syncthreads();
    { const int n = tid & 127, kq = tid >> 7;
      const unsigned cm = cmax[drow0 + n]; const float am = u2f(cm);
      float sc, swv;
      if (F8) { int ex = 0; if (am > 0.f) ex = 7 - ((int)((cm >> 23) & 0xffu) - 127); ex -= 1; sc = __builtin_ldexpf(1.0f, ex); swv = __builtin_ldexpf(1.0f, -ex); }
      else { sc = am > 0.f ? 127.0f / am : 0.f; swv = am * (1.0f / 127.0f); }
      const LAS float* sp = scr + (32 * kq) * 132 + n;
      unsigned o[8];
#pragma unroll
      for (int q = 0; q < 8; ++q) { const float a = sp[(4 * q + 0) * 132] * sc, b = sp[(4 * q + 1) * 132] * sc, c = sp[(4 * q + 2) * 132] * sc, d = sp[(4 * q + 3) * 132] * sc;
          if (F8) o[q] = pg8::pk4_fp8(a, b, c, d);
          else o[q] = ((unsigned)(int)__builtin_rintf(a) & 0xffu) | (((unsigned)(int)__builtin_rintf(b) & 0xffu) << 8) | (((unsigned)(int)__builtin_rintf(c) & 0xffu) << 16) | (((unsigned)(int)__builtin_rintf(d) & 0xffu) << 24); }
      v4u* dst = (v4u*)(WT + (size_t)(drow0 + n) * K + k0 + 32 * kq);
      v4u o0, o1; o0.x = o[0]; o0.y = o[1]; o0.z = o[2]; o0.w = o[3]; o1.x = o[4]; o1.y = o[5]; o1.z = o[6]; o1.w = o[7];
      dst[0] = o0; dst[1] = o1;
      if (kb == 0 && kq == 0) sw[drow0 + n] = swv; }
    __syncthreads();
}
struct WPtrs { const float *sgu_in, *sgu_out, *ffn_gu, *ffn_dn, *ret_in, *ret_out, *moe_gu, *moe_dn; };
constexpr int CI0 = (D / 64) * (2 * SGW / 32), CI1 = (SGW / 64) * (D / 32), CI2 = (D / 64) * (2 * FF / 32), CI3 = (FF / 64) * (D / 32), CI4 = (D / 64) * (RET_IN / 32), CI5 = (RH * RDV / 64) * (D / 32);
__device__ __forceinline__ void cvt_phase_a(const WPtrs& P, unsigned char* ws, LAS unsigned char* lds, int gw, int NGW, int wave, int lane) {
    LAS float* scr = (LAS float*)(lds + wave * 16384);
    unsigned* cmax = (unsigned*)(ws + WS_CTL + CTL_COLMAX);
    constexpr int AI0 = (D / AMK) * (2 * SGW / 256), AI2 = (D / AMK) * (2 * FF / 256), AI3 = (FF / AMK) * (D / 256), AI4 = (D / AMK) * (RET_IN / 256), AI5 = (RH * RDV / AMK) * (D / 256);
    static_assert(D % AMK == 0 && FF % AMK == 0 && (RH * RDV) % AMK == 0 && FF % 256 == 0 && (2 * SGW) % 256 == 0 && RET_IN % 256 == 0, "absmax item shape");
    constexpr int NIT = CI1 + AI3 + AI5 + NE * AI3 + AI0 + AI2 + AI4 + NE * AI2;
    for (int it = gw; it < NIT; it += NGW) {
        int r = it;
        if (r < CI1) { cvt_item<0>(P.sgu_out, SGW, D, (bf16*)(ws + WS_W_SGU_OUT), scr, r, lane); continue; } r -= CI1;
        if (r < AI3) { amax_item<0>(P.ffn_dn, FF, D, cmax + SW_FD, r, lane); continue; } r -= AI3;
        if (r < AI5) { amax_item<0>(P.ret_out, RH * RDV, D, cmax + SW_RO, r, lane); continue; } r -= AI5;
        if (r < NE * AI3) { const int e = r / AI3; amax_item<0>(P.moe_dn + (size_t)e * FF * D, FF, D, cmax + SW_MD + e * D, r % AI3, lane); continue; } r -= NE * AI3;
        if (r < AI0) { amax_item<0>(P.sgu_in, D, 2 * SGW, cmax + SW_SGU, r, lane); continue; } r -= AI0;
        if (r < AI2) { amax_item<1>(P.ffn_gu, D, 2 * FF, cmax + SW_FFN, r, lane); continue; } r -= AI2;
        if (r < AI4) { amax_item<0>(P.ret_in, D, RET_IN, cmax + SW_RET, r, lane); continue; } r -= AI4;
        { const int e = r / AI2; amax_item<1>(P.moe_gu + (size_t)e * D * 2 * FF, D, 2 * FF, cmax + SW_MOE + e * 2 * FF, r % AI2, lane); }
    }
}
__device__ __forceinline__ void cvt_phase_b(const WPtrs& P, unsigned char* ws, LAS unsigned char* lds, int bid, int G, int tid) {
    LAS float* scr = (LAS float*)lds;
    const unsigned* cmax = (const unsigned*)(ws + WS_CTL + CTL_COLMAX); float* sw = (float*)(ws + WS_SW);
    constexpr int T0 = (D / 128) * (2 * SGW / 128), T2 = (D / 128) * (2 * FF / 128), T3 = (FF / 128) * (D / 128), T4 = (D / 128) * (RET_IN / 128), T5 = (RH * RDV / 128) * (D / 128);
    static_assert(FF % 128 == 0 && D % 128 == 0 && RET_IN % 128 == 0 && (2 * SGW) % 128 == 0 && (RH * RDV) % 128 == 0, "pass-B tile shape");
    constexpr int NIT = T3 + NE * T3 + T5 + T0 + T2 + T4 + NE * T2;
    for (int it = bid; it < NIT; it += G) {
        int r = it;
        if (r < T3) { cvtq_tile<0, true>(P.ffn_dn, FF, D, (unsigned char*)(ws + WS_W_FFN_DN), cmax + SW_FD, sw + SW_FD, scr, r, tid); continue; } r -= T3;
        if (r < NE * T3) { const int e = r / T3; cvtq_tile<0, true>(P.moe_dn + (size_t)e * FF * D, FF, D, (unsigned char*)(ws + WS_W_MOE_DN) + (size_t)e * D * FF, cmax + SW_MD + e * D, sw + SW_MD + e * D, scr, r % T3, tid); continue; } r -= NE * T3;
        if (r < T5) { cvtq_tile<0, false>(P.ret_out, RH * RDV, D, (unsigned char*)(ws + WS_W_RET_OUT), cmax + SW_RO, sw + SW_RO, scr, r, tid); continue; } r -= T5;
        if (r < T0) { cvtq_tile<0, false>(P.sgu_in, D, 2 * SGW, (unsigned char*)(ws + WS_W_SGU_IN), cmax + SW_SGU, sw + SW_SGU, scr, r, tid); continue; } r -= T0;
        if (r < T2) { cvtq_tile<1, false>(P.ffn_gu, D, 2 * FF, (unsigned char*)(ws + WS_W_FFN_GU), cmax + SW_FFN, sw + SW_FFN, scr, r, tid); continue; } r -= T2;
        if (r < T4) { cvtq_tile<0, false>(P.ret_in, D, RET_IN, (unsigned char*)(ws + WS_W_RET_IN), cmax + SW_RET, sw + SW_RET, scr, r, tid); continue; } r -= T4;
        { const int e = r / T2; cvtq_tile<1, false>(P.moe_gu + (size_t)e * D * 2 * FF, D, 2 * FF, (unsigned char*)(ws + WS_W_MOE_GU) + (size_t)e * 2 * FF * D, cmax + SW_MOE + e * 2 * FF, sw + SW_MOE + e * 2 * FF, scr, r % T2, tid); }
    }
}
__device__ __forceinline__ float wave_max(float v, int lane) {
    (void)lane;
    v = fmaxf(v, dpp_f<0xB1>(v)); v = fmaxf(v, dpp_f<0x4E>(v)); v = fmaxf(v, dpp_f<0x141>(v)); v = fmaxf(v, dpp_f<0x140>(v));
    return fmaxf(fmaxf(rdl_f(v, 0), rdl_f(v, 16)), fmaxf(rdl_f(v, 32), rdl_f(v, 48)));
}
__device__ __forceinline__ float quant_row_store(const f32x4 (&o)[4], signed char* dst, int lane) {
    float am = 0.f;
#pragma unroll
    for (int j = 0; j < 4; ++j) am = fmaxf(fmaxf(am, fmaxf(fabsf(o[j].x), fabsf(o[j].y))), fmaxf(fabsf(o[j].z), fabsf(o[j].w)));
    am = wave_max(am, lane); const float inv = am > 0.f ? 127.0f / am : 0.f;
    unsigned* d4 = (unsigned*)dst + lane;
#pragma unroll
    for (int j = 0; j < 4; ++j) { const int q0 = (int)__builtin_rintf(o[j].x * inv), q1 = (int)__builtin_rintf(o[j].y * inv), q2 = (int)__builtin_rintf(o[j].z * inv), q3 = (int)__builtin_rintf(o[j].w * inv);
        d4[64 * j] = ((unsigned)q0 & 0xffu) | (((unsigned)q1 & 0xffu) << 8) | (((unsigned)q2 & 0xffu) << 16) | (((unsigned)q3 & 0xffu) << 24); }
    return am * (1.0f / 127.0f);
}
template <bool XBF>
__device__ __forceinline__ void norm_phase(const void* X, const bf16* delta, bf16* X16out, const float* g, const float* msh, const float* ms, signed char* XN, float* SA, int gw, int NGW, int lane) {
    const int wpb = NGW / NB, b = gw / wpb, r0 = gw - b * wpb;
    if (b >= NB) return;
    f32x4 ga[4], hv[4];
    { const f32x4* gp = (const f32x4*)g + lane; const f32x4* sp = (const f32x4*)(ms + (size_t)b * MODW) + lane; const f32x4* hp = (const f32x4*)(msh + (size_t)b * MODW) + lane;
#pragma unroll
      for (int j = 0; j < 4; ++j) { ga[j] = gp[64 * j] * (1.0f + sp[64 * j]); hv[j] = hp[64 * j]; } }
    for (int r = r0; r < SEQ; r += 2 * wpb) {
        int mm[2]; mm[0] = b * SEQ + r; mm[1] = b * SEQ + (r + wpb < SEQ ? r + wpb : r);
        f32x4 v[2][4]; v2u dd[2][4];
#pragma unroll
        for (int q = 0; q < 2; ++q)
#pragma unroll
            for (int j = 0; j < 4; ++j) {
                if (XBF) { const v2u xx = ((const v2u*)((const bf16*)X + (size_t)mm[q] * D) + lane)[64 * j]; v[q][j] = (f32x4){bflo(xx.x), bfhi(xx.x), bflo(xx.y), bfhi(xx.y)}; }
                else v[q][j] = ((const f32x4*)((const float*)X + (size_t)mm[q] * D) + lane)[64 * j];
                if (delta) dd[q][j] = ((const v2u*)(delta + (size_t)mm[q] * D) + lane)[64 * j]; }
#pragma unroll
        for (int q = 0; q < 2; ++q) { const int m = mm[q]; float ss = 0.f;
#pragma unroll
            for (int j = 0; j < 4; ++j) {
                if (delta) { const v2u d2 = dd[q][j]; v[q][j].x += bflo(d2.x); v[q][j].y += bfhi(d2.x); v[q][j].z += bflo(d2.y); v[q][j].w += bfhi(d2.y);
                    v2u w; w.x = pk2(v[q][j].x, v[q][j].y); w.y = pk2(v[q][j].z, v[q][j].w); ((v2u*)(X16out + (size_t)m * D) + lane)[64 * j] = w;
                    v[q][j] = (f32x4){bflo(w.x), bfhi(w.x), bflo(w.y), bfhi(w.y)}; }
                ss += (v[q][j].x * v[q][j].x + v[q][j].y * v[q][j].y) + (v[q][j].z * v[q][j].z + v[q][j].w * v[q][j].w); }
            const float rstd = 1.0f / sqrtf(wave_sum(ss, lane) * (1.0f / D) + EPS);
            f32x4 o[4];
#pragma unroll
            for (int j = 0; j < 4; ++j) o[j] = v[q][j] * rstd * ga[j] + hv[j];
            const float sc = quant_row_store(o, XN + (size_t)m * D, lane);
            if (lane == 0) SA[m] = sc; }
    }
}
typedef short s16x4 __attribute__((ext_vector_type(4)));
typedef short bfx8 __attribute__((ext_vector_type(8)));
__device__ __forceinline__ s16x4 ds_tr(LAS unsigned char* p) { return __builtin_amdgcn_ds_read_tr16_b64_v4i16((LAS s16x4*)p); }
__device__ __forceinline__ bfx8 cat8(s16x4 a, s16x4 b) { return __builtin_shufflevector(a, b, 0, 1, 2, 3, 4, 5, 6, 7); }
__device__ __forceinline__ bfx8 pack8(const f32x4& lo, const f32x4& hi) { v4u w; w.x = pg8::cvt_pk_bf16(lo[0], lo[1]); w.y = pg8::cvt_pk_bf16(lo[2], lo[3]); w.z = pg8::cvt_pk_bf16(hi[0], hi[1]); w.w = pg8::cvt_pk_bf16(hi[2], hi[3]); return __builtin_bit_cast(bfx8, w); }
#define MFMA16(a, b, c) __builtin_amdgcn_mfma_f32_16x16x32_bf16((a), (b), (c), 0, 0, 0)

constexpr int SG_WP = 272, SG_VP = 528, SG_W_OFF = 0, SG_V_OFF = 128 * SG_WP, SG_ST_OFF = SG_V_OFF + 128 * SG_VP;
__device__ __forceinline__ void sgate_mfma(bf16* U, const bf16* V, const float2* vstat, const float* lng, const float* lnb, const float* w_s, const float* b_s,
                                           LAS unsigned char* lds, int tid, int bid, int G) {
    const int lane = tid & 63, wave = __builtin_amdgcn_readfirstlane(tid >> 6), l15 = lane & 15, q = lane >> 4;
    LAS unsigned char* Wb = lds + SG_W_OFF; LAS unsigned char* vn = lds + SG_V_OFF; LAS float* st = (LAS float*)(lds + SG_ST_OFF);
    constexpr int NU = (M / CH) * NGRP;
    int gprev = -1;
    f32x4 g0 = {0.f, 0.f, 0.f, 0.f}, g1 = g0, b0 = g0, b1 = g0;
    v4u vraw[8]; f32x4 sraw[4];
#define SG_LOADV(uu_) { const int g_ = (uu_) & 7, n_ = (uu_) >> 3; \
        _Pragma("unroll") for (int i = 0; i < 8; ++i) vraw[i] = *(const v4u*)(V + (size_t)(n_ * CH + (tid >> 5) + 16 * i) * SGW + g_ * 256 + (tid & 31) * 8); \
        const f32x4* sp_ = (const f32x4*)(vstat + (size_t)(n_ * CH + (tid >> 2)) * 32 + (tid & 3) * 8); \
        _Pragma("unroll") for (int i = 0; i < 4; ++i) sraw[i] = sp_[i]; }
    if (bid < NU) SG_LOADV(bid)
    for (int unit = bid; unit < NU; unit += G) {
        const int g = unit & 7, n = unit >> 3;
        __syncthreads();
        if (g != gprev) { gprev = g;
            for (int i = tid; i < CH * CH / 4; i += 512) { const int t = i >> 5, s4 = (i & 31) * 4; f32x4 w = *(const f32x4*)(w_s + (size_t)g * CH * CH + t * CH + s4);
                if (s4 + 0 > t) w.x = 0.f; if (s4 + 1 > t) w.y = 0.f; if (s4 + 2 > t) w.z = 0.f; if (s4 + 3 > t) w.w = 0.f;
                v2u o; o.x = pk2(w.x, w.y); o.y = pk2(w.z, w.w); *(LAS v2u*)(Wb + t * SG_WP + s4 * 2) = o; }
            const int col = g * 256 + (tid & 31) * 8;
            g0 = *(const f32x4*)(lng + col); g1 = *(const f32x4*)(lng + col + 4); b0 = *(const f32x4*)(lnb + col); b1 = *(const f32x4*)(lnb + col + 4); }
        { float sx = (sraw[0].x + sraw[0].z) + (sraw[1].x + sraw[1].z) + (sraw[2].x + sraw[2].z) + (sraw[3].x + sraw[3].z);
          float sq = (sraw[0].y + sraw[0].w) + (sraw[1].y + sraw[1].w) + (sraw[2].y + sraw[2].w) + (sraw[3].y + sraw[3].w);
          sx += dpp_f<0xB1>(sx); sx += dpp_f<0x4E>(sx); sq += dpp_f<0xB1>(sq); sq += dpp_f<0x4E>(sq);
          const float mean = sx * (1.0f / SGW); const float var = sq * (1.0f / SGW) - mean * mean;
          if ((tid & 3) == 0) { st[2 * (tid >> 2)] = mean; st[2 * (tid >> 2) + 1] = 1.0f / sqrtf(var + EPS); } }
        __syncthreads();
#pragma unroll
        for (int i = 0; i < 8; ++i) { const int r = (tid >> 5) + 16 * i, c8 = (tid & 31) * 8;
            const v4u raw = vraw[i]; const float mean = st[2 * r], rstd = st[2 * r + 1];
            v4u o; o.x = pk2((bflo(raw.x) - mean) * rstd * g0.x + b0.x, (bfhi(raw.x) - mean) * rstd * g0.y + b0.y); o.y = pk2((bflo(raw.y) - mean) * rstd * g0.z + b0.z, (bfhi(raw.y) - mean) * rstd * g0.w + b0.w);
            o.z = pk2((bflo(raw.z) - mean) * rstd * g1.x + b1.x, (bfhi(raw.z) - mean) * rstd * g1.y + b1.y); o.w = pk2((bflo(raw.w) - mean) * rstd * g1.z + b1.z, (bfhi(raw.w) - mean) * rstd * g1.w + b1.w);
            *(LAS v4u*)(vn + r * SG_VP + c8 * 2) = o; }
        v2u uu[8][2];
#pragma unroll
        for (int T = 0; T < 8; ++T)
#pragma unroll
            for (int ct = 0; ct < 2; ++ct) uu[T][ct] = *(const v2u*)(U + (size_t)(n * CH + 16 * T + l15) * SGW + g * 256 + 32 * wave + 16 * ct + 4 * q);
        { const int nu = unit + G < NU ? unit + G : unit; SG_LOADV(nu) }
        __syncthreads();
        bfx8 af[4][2];
#pragma unroll
        for (int ks = 0; ks < 4; ++ks)
#pragma unroll
            for (int ct = 0; ct < 2; ++ct) { LAS unsigned char* p0 = vn + (32 * ks + 8 * q + (l15 >> 2)) * SG_VP + (32 * wave + 16 * ct + 4 * (l15 & 3)) * 2; af[ks][ct] = cat8(ds_tr(p0), ds_tr(p0 + 4 * SG_VP)); }
        f32x4 acc[2][8];
#pragma unroll
        for (int T = 0; T < 8; ++T) { acc[0][T] = (f32x4){0.f, 0.f, 0.f, 0.f}; acc[1][T] = (f32x4){0.f, 0.f, 0.f, 0.f};
#pragma unroll
            for (int ks = 0; ks <= T / 2; ++ks) { const bfx8 bfr = *(const LAS bfx8*)(Wb + (16 * T + l15) * SG_WP + (32 * ks + 8 * q) * 2);
                acc[0][T] = MFMA16(af[ks][0], bfr, acc[0][T]); acc[1][T] = MFMA16(af[ks][1], bfr, acc[1][T]); } }
#pragma unroll
        for (int T = 0; T < 8; ++T) { const int t = 16 * T + l15; const float bs = b_s[g * CH + t];
#pragma unroll
            for (int ct = 0; ct < 2; ++ct) { bf16* up = U + (size_t)(n * CH + t) * SGW + g * 256 + 32 * wave + 16 * ct + 4 * q; const v2u u2 = uu[T][ct]; const f32x4 a = acc[ct][T];
                v2u o; o.x = pk2(pg8::gelu_f(bflo(u2.x)) * (a[0] + bs), pg8::gelu_f(bfhi(u2.x)) * (a[1] + bs)); o.y = pk2(pg8::gelu_f(bflo(u2.y)) * (a[2] + bs), pg8::gelu_f(bfhi(u2.y)) * (a[3] + bs)); *(v2u*)up = o; } }
    }
#undef SG_LOADV
}

constexpr int RT_PK = 528, RT_PV = 144, RT_KS = 0, RT_VS = 128 * RT_PK, RT_SF = RT_VS + 128 * RT_PV;
static_assert(RT_SF + 32768 <= RING_BYTES, "retention LDS map");
__device__ __forceinline__ void ret_mfma(const bf16* Q, const bf16* Kb, bf16* VO, float* rstat, LAS unsigned char* lds, int tid, int bid, int G) {
    const int lane = tid & 63, wave = __builtin_amdgcn_readfirstlane(tid >> 6), l15 = lane & 15, q = lane >> 4;
    const int tt = wave < 4 ? wave : 11 - wave;
    LAS unsigned char* KS = lds + RT_KS; LAS unsigned char* VS = lds + RT_VS; LAS unsigned char* SF = lds + RT_SF;
    for (int u0 = bid; u0 < NB * RH * 8; u0 += G) {
        const int unit = (G == 256) ? ((u0 & 7) * 32 + (u0 >> 3)) : u0;
        const int b = unit >> 5, h = (unit >> 3) & 3, js = unit & 7;
        const float cd = __builtin_amdgcn_exp2f(128.0f * __builtin_amdgcn_logf(1.0f - __builtin_amdgcn_exp2f(-5.0f - (float)h)));
        f32x4 S[2][4];
#pragma unroll
        for (int ci = 0; ci < 2; ++ci)
#pragma unroll
            for (int vt = 0; vt < 4; ++vt) S[ci][vt] = (f32x4){0.f, 0.f, 0.f, 0.f};
        const char* kbase = (const char*)(Kb + (size_t)(b * SEQ) * D + h * RDK); const char* vbase = (const char*)(VO + (size_t)(b * SEQ) * (RH * RDV) + h * RDV + js * 64);
        const char* qbase = (const char*)(Q + (size_t)(b * SEQ) * D + h * RDK);
        const unsigned koff = (unsigned)((tid >> 5) * D + (tid & 31) * 8) * 2u, voff = (unsigned)((tid >> 3) * (RH * RDV) + (tid & 7) * 8) * 2u, qoff = (unsigned)((16 * tt + l15) * D + 8 * q) * 2u;
        __syncthreads();
#pragma unroll
        for (int i = 0; i < 4; ++i) *(LAS v4u*)(SF + (tid + 512 * i) * 16) = (v4u){0u, 0u, 0u, 0u};
        v4u kr[8], vr[2];
#pragma unroll
        for (int i = 0; i < 8; ++i) kr[i] = *(const v4u*)(kbase + (size_t)i * 16 * D * 2 + koff);
#pragma unroll
        for (int i = 0; i < 2; ++i) vr[i] = *(const v4u*)(vbase + (size_t)i * 64 * (RH * RDV) * 2 + voff);
#pragma unroll
        for (int i = 0; i < 8; ++i) { const int p = tid + 512 * i; *(LAS v4u*)(KS + (p >> 5) * RT_PK + (p & 31) * 16) = kr[i]; }
#pragma unroll
        for (int i = 0; i < 2; ++i) { const int p = tid + 512 * i; *(LAS v4u*)(VS + (p >> 3) * RT_PV + (p & 7) * 16) = vr[i]; }
        bfx8 qf[8];
#pragma unroll
        for (int ks = 0; ks < 8; ++ks) qf[ks] = *(const bfx8*)(qbase + 64 * ks + qoff);
        __syncthreads();
        for (int n = 0; n < SEQ / CH; ++n) {
            const int rowbase = b * SEQ + n * CH;
            const int nn = (n + 1 < SEQ / CH) ? n + 1 : n;
#pragma unroll
            for (int i = 0; i < 8; ++i) kr[i] = *(const v4u*)(kbase + (size_t)(nn * CH + i * 16) * D * 2 + koff);
#pragma unroll
            for (int i = 0; i < 2; ++i) vr[i] = *(const v4u*)(vbase + (size_t)(nn * CH + i * 64) * (RH * RDV) * 2 + voff);
            f32x4 pacc[8];
#pragma unroll
            for (int Si = 0; Si < 8; ++Si) { pacc[Si] = (f32x4){0.f, 0.f, 0.f, 0.f};
                if (Si <= tt) {
                    bfx8 ka[8];
#pragma unroll
                    for (int ks = 0; ks < 8; ++ks) ka[ks] = *(const LAS bfx8*)(KS + (16 * Si + l15) * RT_PK + (32 * ks + 8 * q) * 2);
                    __builtin_amdgcn_sched_barrier(0);
#pragma unroll
                    for (int ks = 0; ks < 8; ++ks) pacc[Si] = MFMA16(ka[ks], qf[ks], pacc[Si]);
                    if (Si == tt) {
#pragma unroll
                        for (int e = 0; e < 4; ++e) if (4 * q + e > l15) pacc[Si][e] = 0.f; } } }
            f32x4 oacc[4];
#pragma unroll
            for (int vt = 0; vt < 4; ++vt) oacc[vt] = (f32x4){0.f, 0.f, 0.f, 0.f};
#pragma unroll
            for (int k2 = 0; k2 < 4; ++k2) { bfx8 sf[2][4];
#pragma unroll
                for (int kq = 0; kq < 2; ++kq)
#pragma unroll
                    for (int vt = 0; vt < 4; ++vt) sf[kq][vt] = *(const LAS bfx8*)(SF + (((2 * k2 + kq) * 4 + vt) * 64 + lane) * 16);
                __builtin_amdgcn_sched_barrier(0);
#pragma unroll
                for (int kq = 0; kq < 2; ++kq)
#pragma unroll
                    for (int vt = 0; vt < 4; ++vt) oacc[vt] = MFMA16(sf[kq][vt], qf[2 * k2 + kq], oacc[vt]);
                __builtin_amdgcn_sched_barrier(0); }
#pragma unroll
            for (int kk = 0; kk < 4; ++kk) if (2 * kk <= tt) { const bfx8 pf = pack8(pacc[2 * kk], pacc[2 * kk + 1]);
                bfx8 vf[4];
#pragma unroll
                for (int vt = 0; vt < 4; ++vt) { LAS unsigned char* p0 = VS + (32 * kk + 4 * q + (l15 >> 2)) * RT_PV + (16 * vt + 4 * (l15 & 3)) * 2; vf[vt] = cat8(ds_tr(p0), ds_tr(p0 + 16 * RT_PV)); }
                __builtin_amdgcn_sched_barrier(0);
#pragma unroll
                for (int vt = 0; vt < 4; ++vt) oacc[vt] = MFMA16(vf[vt], pf, oacc[vt]); }
            { const size_t row = (size_t)(rowbase + 16 * tt + l15); float ss = 0.f;
#pragma unroll
              for (int vt = 0; vt < 4; ++vt) { const f32x4 o = oacc[vt]; ss += (o[0] * o[0] + o[1] * o[1]) + (o[2] * o[2] + o[3] * o[3]);
                  v2u w; w.x = pg8::cvt_pk_bf16(o[0], o[1]); w.y = pg8::cvt_pk_bf16(o[2], o[3]); *(v2u*)(VO + row * (RH * RDV) + h * RDV + js * 64 + 16 * vt + 4 * q) = w; }
              ss += shx(ss, 16, lane); ss += shx(ss, 32, lane);
              if (q == 0) rstat[(row * RH + h) * 8 + js] = ss; }
#pragma unroll
            for (int ks = 0; ks < 8; ++ks) qf[ks] = *(const bfx8*)(qbase + (size_t)(nn * CH) * D * 2 + 64 * ks + qoff);
#pragma unroll
            for (int kk = 0; kk < 4; ++kk) { bfx8 vfn[4];
#pragma unroll
                for (int vt = 0; vt < 4; ++vt) { LAS unsigned char* p0 = VS + (32 * kk + 8 * q + (l15 >> 2)) * RT_PV + (16 * vt + 4 * (l15 & 3)) * 2; vfn[vt] = cat8(ds_tr(p0), ds_tr(p0 + 4 * RT_PV)); }
                bfx8 af[2];
#pragma unroll
                for (int ci = 0; ci < 2; ++ci) { LAS unsigned char* p0 = KS + (32 * kk + 8 * q + (l15 >> 2)) * RT_PK + (32 * wave + 8 * (l15 & 3) + 4 * ci) * 2; af[ci] = cat8(ds_tr(p0), ds_tr(p0 + 4 * RT_PK)); }
                __builtin_amdgcn_sched_barrier(0);
#pragma unroll
                for (int ci = 0; ci < 2; ++ci)
#pragma unroll
                    for (int vt = 0; vt < 4; ++vt) S[ci][vt] = MFMA16(af[ci], vfn[vt], S[ci][vt]);
                __builtin_amdgcn_sched_barrier(0); }
#pragma unroll
            for (int ci = 0; ci < 2; ++ci)
#pragma unroll
                for (int vt = 0; vt < 4; ++vt) S[ci][vt] = S[ci][vt] * cd;
            __syncthreads();
#pragma unroll
            for (int vt = 0; vt < 4; ++vt) *(LAS bfx8*)(SF + ((wave * 4 + vt) * 64 + lane) * 16) = pack8(S[0][vt], S[1][vt]);
#pragma unroll
            for (int i = 0; i < 8; ++i) { const int p = tid + 512 * i; *(LAS v4u*)(KS + (p >> 5) * RT_PK + (p & 31) * 16) = kr[i]; }
#pragma unroll
            for (int i = 0; i < 2; ++i) { const int p = tid + 512 * i; *(LAS v4u*)(VS + (p >> 3) * RT_PV + (p & 7) * 16) = vr[i]; }
            __syncthreads();
        }
    }
}
__device__ __forceinline__ void ognorm_phase(const bf16* O, const bf16* Gs, const float* rstat, signed char* OG8, float* SA, int gw, int NGW, int lane) {
    float stn[2]; v4u ovn[2][RH], gvn[2][RH];
#define OGN_LOAD(mm) _Pragma("unroll") for (int r = 0; r < 2; ++r) { stn[r] = rstat[(size_t)((mm) + r) * (RH * 8) + (lane & 31)]; \
        _Pragma("unroll") for (int h = 0; h < RH; ++h) { const size_t off = (size_t)((mm) + r) * (RH * RDV) + h * RDV + lane * 8; ovn[r][h] = *(const v4u*)(O + off); gvn[r][h] = *(const v4u*)(Gs + off); } }
    OGN_LOAD(2 * gw)
    for (int m0 = 2 * gw; m0 < M; m0 += 2 * NGW) {
        float st[2]; v4u ov[2][RH], gv[2][RH];
#pragma unroll
        for (int r = 0; r < 2; ++r) { st[r] = stn[r];
#pragma unroll
            for (int h = 0; h < RH; ++h) { ov[r][h] = ovn[r][h]; gv[r][h] = gvn[r][h]; } }
        { const int mn = m0 + 2 * NGW < M ? m0 + 2 * NGW : m0; OGN_LOAD(mn) }
#pragma unroll
        for (int r = 0; r < 2; ++r) {
            float s8 = st[r]; s8 += dpp_f<0xB1>(s8); s8 += dpp_f<0x4E>(s8); s8 += dpp_f<0x141>(s8);
            const float rq = 1.0f / sqrtf(s8 * (1.0f / RDV) + EPS);
            float v[RH][8]; float am = 0.f;
#pragma unroll
            for (int h = 0; h < RH; ++h) { const float rr = rdl_f(rq, 8 * h); const v4u o4 = ov[r][h], g4 = gv[r][h];
                v[h][0] = bflo(o4.x) * rr * pg8::silu_f(bflo(g4.x)); v[h][1] = bfhi(o4.x) * rr * pg8::silu_f(bfhi(g4.x)); v[h][2] = bflo(o4.y) * rr * pg8::silu_f(bflo(g4.y)); v[h][3] = bfhi(o4.y) * rr * pg8::silu_f(bfhi(g4.y));
                v[h][4] = bflo(o4.z) * rr * pg8::silu_f(bflo(g4.z)); v[h][5] = bfhi(o4.z) * rr * pg8::silu_f(bfhi(g4.z)); v[h][6] = bflo(o4.w) * rr * pg8::silu_f(bflo(g4.w)); v[h][7] = bfhi(o4.w) * rr * pg8::silu_f(bfhi(g4.w));
#pragma unroll
                for (int e = 0; e < 8; ++e) am = fmaxf(am, fabsf(v[h][e])); }
            am = wave_max(am, lane); const float inv = am > 0.f ? 127.0f / am : 0.f;
#pragma unroll
            for (int h = 0; h < RH; ++h) { unsigned w0 = 0u, w1 = 0u;
#pragma unroll
                for (int e = 0; e < 4; ++e) { const int q0 = (int)__builtin_rintf(v[h][e] * inv), q1 = (int)__builtin_rintf(v[h][4 + e] * inv); w0 |= ((unsigned)q0 & 0xffu) << (8 * e); w1 |= ((unsigned)q1 & 0xffu) << (8 * e); }
                v2u o; o.x = w0; o.y = w1; *(v2u*)(OG8 + (size_t)(m0 + r) * (RH * RDV) + h * RDV + lane * 8) = o; }
            if (lane == 0) SA[m0 + r] = am * (1.0f / 127.0f);
        }
    }
}
__device__ __forceinline__ void route_phase(bf16* X, const bf16* delta, const float* g, const float* msh, const float* ms, const float* wr, const float* br, signed char* XN, float* SA, v4u* route, int* table,
                                            LAS unsigned char* lds, int tid, int lane, int wave, int bid, int G) {
    LAS int* cnt = (LAS int*)lds;
    f32x4 wq[4][4][2], gq[4];
#pragma unroll
    for (int j = 0; j < 4; ++j) { gq[j] = ((const f32x4*)g + lane)[64 * j];
        const f32x4* wp = (const f32x4*)(wr + (size_t)((lane + 64 * j) * 4) * NE);
#pragma unroll
        for (int qq = 0; qq < 4; ++qq) { wq[j][qq][0] = wp[2 * qq]; wq[j][qq][1] = wp[2 * qq + 1]; } }
    for (int blk = bid; blk < M / 128; blk += G) {
        __syncthreads();
        if (tid < 8) cnt[tid] = 0;
        __syncthreads();
        const int b = (blk * 128) / SEQ;
        f32x4 ga[4], hv[4];
        { const f32x4* sp = (const f32x4*)(ms + (size_t)b * MODW) + lane; const f32x4* hp = (const f32x4*)(msh + (size_t)b * MODW) + lane;
#pragma unroll
          for (int j = 0; j < 4; ++j) { ga[j] = gq[j] * (1.0f + sp[64 * j]); hv[j] = hp[64 * j]; } }
        for (int i = 0; i < 16; ++i) {
            const int m = blk * 128 + wave * 16 + i;
            v2u* xr = (v2u*)(X + (size_t)m * D) + lane;
            f32x4 v[4]; float ss = 0.f;
#pragma unroll
            for (int j = 0; j < 4; ++j) { const v2u xx = xr[64 * j]; const v2u dd = ((const v2u*)(delta + (size_t)m * D) + lane)[64 * j];
                v2u w; w.x = pk2(bflo(xx.x) + bflo(dd.x), bfhi(xx.x) + bfhi(dd.x)); w.y = pk2(bflo(xx.y) + bflo(dd.y), bfhi(xx.y) + bfhi(dd.y)); xr[64 * j] = w;
                v[j] = (f32x4){bflo(w.x), bfhi(w.x), bflo(w.y), bfhi(w.y)};
                ss += (v[j].x * v[j].x + v[j].y * v[j].y) + (v[j].z * v[j].z + v[j].w * v[j].w); }
            const float rstd = 1.0f / sqrtf(wave_sum(ss, lane) * (1.0f / D) + EPS);
            float lg[NE]; f32x4 oo[4];
#pragma unroll
            for (int e = 0; e < NE; ++e) lg[e] = 0.f;
#pragma unroll
            for (int j = 0; j < 4; ++j) { const f32x4 o = v[j] * rstd * ga[j] + hv[j]; oo[j] = o;
#pragma unroll
                for (int qq = 0; qq < 4; ++qq) { const f32x4 w0 = wq[j][qq][0], w1 = wq[j][qq][1]; const float hk = o[qq];
                    lg[0] += hk * w0.x; lg[1] += hk * w0.y; lg[2] += hk * w0.z; lg[3] += hk * w0.w; lg[4] += hk * w1.x; lg[5] += hk * w1.y; lg[6] += hk * w1.z; lg[7] += hk * w1.w; } }
#pragma unroll
            for (int e = 0; e < NE; ++e) lg[e] = wave_sum(lg[e], lane) + br[e];
            { const float sc = quant_row_store(oo, XN + (size_t)m * D, lane); if (lane == 0) SA[m] = sc; }
            int i1 = 0; float l1 = lg[0];
#pragma unroll
            for (int e = 1; e < NE; ++e) if (lg[e] > l1) { l1 = lg[e]; i1 = e; }
            int i2 = -1; float l2 = -3.0e38f;
#pragma unroll
            for (int e = 0; e < NE; ++e) if (e != i1 && lg[e] > l2) { l2 = lg[e]; i2 = e; }
            const float w1 = 1.0f / (1.0f + __expf(l2 - l1)), w2 = 1.0f - w1;
            if (lane == 0) { v4u r; r.x = (unsigned)i1; r.y = (unsigned)i2; r.z = __builtin_bit_cast(unsigned, w1); r.w = __builtin_bit_cast(unsigned, w2); route[m] = r;
                atomicAdd((int*)(cnt + i1), 1); atomicAdd((int*)(cnt + i2), 1); }
        }
        __syncthreads();
        if (tid < 8) table[blk * 8 + tid] = cnt[tid];
    }
}
__device__ __forceinline__ void sort_phase(const v4u* route, const int* table, const float* SA, unsigned char* listb, LAS unsigned char* lds, int tid, int bid, int G) {
    LAS int* tab = (LAS int*)lds;
    LAS int* ptot = (LAS int*)(lds + 8192);
    LAS int* pmine = (LAS int*)(lds + 8192 + 2048);
    LAS int* tot = (LAS int*)(lds + 8192 + 4096);
    LAS int* ex = (LAS int*)(lds + 8192 + 4096 + 256);
    int* idx = (int*)(listb + LIST_IDX); float* gwt = (float*)(listb + LIST_GW); int* tile_e = (int*)(listb + LIST_TE); int* ntl = (int*)(listb + LIST_NT); float* sal = (float*)(listb + LIST_SAL);
    for (int blk = bid; blk < M / 128; blk += G) {
        __syncthreads();
        for (int i = tid; i < (M / 128) * 8; i += 512) tab[i] = table[i];
        __syncthreads();
        { const int e = tid & 7, part = tid >> 3; int a = 0, mn = 0;
#pragma unroll
          for (int k = 0; k < 4; ++k) { const int bb = part * 4 + k; const int v = tab[bb * 8 + e]; a += v; if (bb < blk) mn += v; }
          ptot[part * 8 + e] = a; pmine[part * 8 + e] = mn; }
        __syncthreads();
        if (tid < 8) { int a = 0, mn = 0; for (int k = 0; k < 64; ++k) { a += ptot[k * 8 + tid]; mn += pmine[k * 8 + tid]; } tot[tid] = a; tot[8 + tid] = mn; }
        v4u r = (v4u){0u, 0u, 0u, 0u};
        if (tid < 128) { r = route[blk * 128 + tid]; ex[tid] = (int)r.x; ex[128 + tid] = (int)r.y; }
        __syncthreads();
        if (tid == 0) { int base = 0; for (int e = 0; e < NE; ++e) { tot[16 + e] = base; const int nt = (tot[e] + 255) >> 8;
                if (blk == 0) for (int k = 0; k < nt; ++k) tile_e[(base >> 8) + k] = e;
                base += nt * 256; }
            if (blk == 0) ntl[0] = base >> 8; }
        if (tid >= 64 && tid < 72) { const int e = tid - 64; int c = 0; for (int k = 0; k < 128; ++k) c += (ex[k] == e) ? 1 : 0; tot[24 + e] = c; }
        __syncthreads();
        if (blk == 0 && tid < 256) { for (int e = 0; e < NE; ++e) { const int n = tot[e], base = tot[16 + e]; const int pos = base + n + tid; if (pos < base + ((n + 255) & ~255)) { idx[pos] = -1; gwt[pos] = 0.f; sal[pos] = 0.f; } } }
        if (tid < 128) { const int e1 = (int)r.x, e2 = (int)r.y; int r1 = 0, r2 = 0;
            for (int k = 0; k < tid; ++k) { r1 += (ex[k] == e1) ? 1 : 0; r2 += (ex[128 + k] == e2) ? 1 : 0; }
            const int p1 = tot[16 + e1] + tot[8 + e1] + r1, p2 = tot[16 + e2] + tot[8 + e2] + tot[24 + e2] + r2; const int tok = blk * 128 + tid;
            const float sat = SA[tok]; idx[p1] = 2 * tok; gwt[p1] = u2f(r.z); sal[p1] = sat; idx[p2] = 2 * tok + 1; gwt[p2] = u2f(r.w); sal[p2] = sat; }
    }
}
__device__ __forceinline__ void final_phase(float* out, const bf16* X16, const bf16* P0, const bf16* P1, const float* g, const float* gate, int gw, int NGW, int lane) {
    const int wpb = NGW / NB, b = gw / wpb, r0 = gw - b * wpb;
    if (b >= NB) return;
    f32x4 gv[4], gt[4];
#pragma unroll
    for (int j = 0; j < 4; ++j) { gv[j] = ((const f32x4*)g + lane)[64 * j]; gt[j] = ((const f32x4*)(gate + (size_t)b * MODW) + lane)[64 * j]; }
    for (int r = r0; r < SEQ; r += 2 * wpb) {
        int mm[2]; mm[0] = b * SEQ + r; mm[1] = b * SEQ + (r + wpb < SEQ ? r + wpb : r);
        v2u x[2][4], a[2][4], c[2][4];
#pragma unroll
        for (int q = 0; q < 2; ++q)
#pragma unroll
            for (int j = 0; j < 4; ++j) { x[q][j] = ((const v2u*)(X16 + (size_t)mm[q] * D) + lane)[64 * j]; a[q][j] = ((const v2u*)(P0 + (size_t)mm[q] * D) + lane)[64 * j]; c[q][j] = ((const v2u*)(P1 + (size_t)mm[q] * D) + lane)[64 * j]; }
#pragma unroll
        for (int q = 0; q < 2; ++q) { f32x4 v[4]; float ss = 0.f;
#pragma unroll
            for (int j = 0; j < 4; ++j) { const v2u xx = x[q][j], aa = a[q][j], bb = c[q][j];
                v[j].x = bflo(xx.x) + gt[j].x * (bflo(aa.x) + bflo(bb.x)); v[j].y = bfhi(xx.x) + gt[j].y * (bfhi(aa.x) + bfhi(bb.x)); v[j].z = bflo(xx.y) + gt[j].z * (bflo(aa.y) + bflo(bb.y)); v[j].w = bfhi(xx.y) + gt[j].w * (bfhi(aa.y) + bfhi(bb.y));
                ss += (v[j].x * v[j].x + v[j].y * v[j].y) + (v[j].z * v[j].z + v[j].w * v[j].w); }
            const float rstd = 1.0f / sqrtf(wave_sum(ss, lane) * (1.0f / D) + EPS);
            f32x4* o = (f32x4*)(out + (size_t)mm[q] * D) + lane;
#pragma unroll
            for (int j = 0; j < 4; ++j) o[64 * j] = v[j] * rstd * gv[j]; }
    }
}

__device__ __forceinline__ const void* karg(int i) { typedef const GAS void* gptr_t; const __attribute__((address_space(4))) gptr_t* ka = (const __attribute__((address_space(4))) gptr_t*)__builtin_amdgcn_kernarg_segment_ptr(); asm volatile("" : "+s"(ka)); return (const void*)ka[i]; }
struct Args { const void* in[22]; float* out; unsigned char* ws; };
__global__ void __launch_bounds__(512, 2) fwd(Args a) {
    extern __shared__ __attribute__((aligned(16))) unsigned char lds_raw[];
    LAS unsigned char* lds = (LAS unsigned char*)lds_raw;
    const int G = gridDim.x, bid = blockIdx.x;
    const int vcu = (G % 8 == 0) ? (bid % 8) * (G / 8) + bid / 8 : bid;
    const int NGW = G * 8;
    const int wave0 = __builtin_amdgcn_readfirstlane((int)threadIdx.x >> 6);
#define FRESH_TID() (wave0 * 64 + fresh_lane())
#define FRESH_IDS() int tid = FRESH_TID(); asm volatile("" : "+v"(tid)); const int lane = tid & 63, wave = wave0; const int gw = vcu * 8 + wave; (void)lane; (void)gw
    unsigned char* const ws0 = a.ws;
#define WS_LOCAL() GAS unsigned char* wsg_ = (GAS unsigned char*)ws0; asm volatile("" : "+s"(wsg_)); unsigned char* ws = (unsigned char*)wsg_
    unsigned char* ws = ws0;
    unsigned* ctl = (unsigned*)(ws + WS_CTL);
    for (int u = threadIdx.x; u < (LDS_BYTES - LDSCTL_OFF) / 4; u += 512) ((LAS unsigned*)(lds + LDSCTL_OFF))[u] = 0u;
    __syncthreads();
    XcdBarrier bar = xcd_barrier_post(ctl + CW_BAR, (volatile LAS unsigned*)(lds + MISC_OFF) + 8);

    float* X = a.out;
    float* MOD = (float*)(ws + WS_MOD);
    signed char* XN = (signed char*)(ws + WS_XN); float* SA = (float*)(ws + WS_SA); const float* SW = (const float*)(ws + WS_SW);
    const float* MOD0 = MOD; const float* MOD1 = MOD + (size_t)NB * MODW;

    { FRESH_IDS(); WS_LOCAL(); mod_phase((const float*)karg(1), (const float*)karg(3), (const float*)karg(4), MOD, lds, tid, lane, wave, bid, G); }
    { FRESH_IDS(); WS_LOCAL(); const WPtrs WP{(const float*)karg(7), (const float*)karg(12), (const float*)karg(13), (const float*)karg(14), (const float*)karg(15), (const float*)karg(16), (const float*)karg(19), (const float*)karg(20)}; cvt_phase_a(WP, ws, lds, gw, NGW, wave, lane); }
    xcd_barrier(bar);
    int vid = bid;
    { volatile LAS unsigned* stw = (volatile LAS unsigned*)(lds + MISC_OFF) + 8;
      if (threadIdx.x == 0) { unsigned ok = (G % 8 == 0) ? 1u : 0u, below = 0u, npop = 0u;
          for (unsigned j = 0; j < 16; ++j) { const unsigned cnt = xb_ld(&ctl[CW_BAR + XB_XCNT(j)]); if (cnt != 0u) { ++npop; if (cnt != (unsigned)G / 8u) ok = 0u; if (j < bar.x) ++below; } }
          if (npop != 8u) ok = 0u;
          stw[3] = ok ? (stw[2] * 8u + below) : (unsigned)bid; }
      __syncthreads();
      vid = __builtin_amdgcn_readfirstlane((int)stw[3]); }
    { FRESH_IDS(); WS_LOCAL(); const WPtrs WP{(const float*)karg(7), (const float*)karg(12), (const float*)karg(13), (const float*)karg(14), (const float*)karg(15), (const float*)karg(16), (const float*)karg(19), (const float*)karg(20)}; cvt_phase_b(WP, ws, lds, bid, G, tid); }
    { FRESH_IDS(); WS_LOCAL(); norm_phase<false>(karg(0), nullptr, nullptr, ((const float*)karg(5)), MOD0 + 0, MOD0 + D, XN, SA, gw, NGW, lane); }
    xcd_barrier(bar);
    { WS_LOCAL(); pg8::Gemm g{(const bf16*)XN, (const bf16*)(ws + WS_W_SGU_IN), D}; pg8::StaticOrder S; S.init(M / 256, 2 * SGW / 256, G, vid, nullptr, nullptr);
      pg8::EpiSguIn E{(bf16*)(ws + WS_U), (bf16*)(ws + WS_V), (float2*)(ws + WS_VSTAT), SA, SW + SW_SGU};
      pg8::gemm_phase<pg8::EpiSguIn, pg8::StaticOrder, true, false, true>(lds, g, S, E, FRESH_TID()); }
    xcd_barrier(bar);
    { FRESH_IDS(); WS_LOCAL(); sgate_mfma((bf16*)(ws + WS_U), (const bf16*)(ws + WS_V), (const float2*)(ws + WS_VSTAT), (const float*)karg(8), (const float*)karg(9), (const float*)karg(10), (const float*)karg(11), lds, tid, bid, G); }
    xcd_barrier(bar);
    { WS_LOCAL(); pg8::Gemm g{(const bf16*)(ws + WS_U), (const bf16*)(ws + WS_W_SGU_OUT), SGW}; pg8::StaticOrder S; S.init(M / 256, D / 256, G, vid, nullptr, nullptr);
      pg8::EpiDelta E{(bf16*)(ws + WS_DELTA), MOD0 + 2 * D, nullptr, nullptr};
      pg8::gemm_phase<pg8::EpiDelta, pg8::StaticOrder, true, false>(lds, g, S, E, FRESH_TID()); }
    xcd_barrier(bar);
    { FRESH_IDS(); WS_LOCAL(); norm_phase<false>(karg(0), (const bf16*)(ws + WS_DELTA), (bf16*)(ws + WS_X16), ((const float*)karg(6)), MOD0 + 3 * D, MOD0 + 4 * D, XN, SA, gw, NGW, lane); }
    xcd_barrier(bar);
    { WS_LOCAL(); pg8::Gemm g{(const bf16*)XN, (const bf16*)(ws + WS_W_FFN_GU), D}; pg8::StaticOrder S; S.init(M / 256, 2 * FF / 256, G, vid, nullptr, nullptr);
      pg8::EpiSwigluF8 E{(unsigned char*)(ws + WS_ACT), FF, SA, SW + SW_FFN};
      pg8::gemm_phase<pg8::EpiSwigluF8, pg8::StaticOrder, true, false, true>(lds, g, S, E, FRESH_TID()); }
    xcd_barrier(bar);
    { WS_LOCAL(); pg8::Gemm g{(const bf16*)(ws + WS_ACT), (const bf16*)(ws + WS_W_FFN_DN), FF}; pg8::StaticOrder S; S.init(M / 256, D / 256, G, vid, nullptr, nullptr);
      pg8::EpiDeltaF8 E{(bf16*)(ws + WS_DELTA), MOD0 + 5 * D, SW + SW_FD, 1.0f / pg8::ACT_F8};
      pg8::gemm_phase<pg8::EpiDeltaF8, pg8::StaticOrder, true, false, false, true>(lds, g, S, E, FRESH_TID()); }
    xcd_barrier(bar);
    { FRESH_IDS(); WS_LOCAL(); norm_phase<true>(ws + WS_X16, (const bf16*)(ws + WS_DELTA), (bf16*)(ws + WS_X16), ((const float*)karg(5)) + D, MOD1 + 0, MOD1 + D, XN, SA, gw, NGW, lane); }
    xcd_barrier(bar);
    { WS_LOCAL(); pg8::Gemm g{(const bf16*)XN, (const bf16*)(ws + WS_W_RET_IN), D}; pg8::StaticOrder S; S.init(M / 256, RET_IN / 256, G, vid, nullptr, nullptr);
      pg8::EpiRetIn E{(bf16*)(ws + WS_Q), (bf16*)(ws + WS_K), (bf16*)(ws + WS_RV), (bf16*)(ws + WS_G), (const int*)karg(2), SA, SW + SW_RET};
      pg8::gemm_phase<pg8::EpiRetIn, pg8::StaticOrder, true, false, true>(lds, g, S, E, FRESH_TID()); }
    xcd_barrier(bar);
    { FRESH_IDS(); WS_LOCAL(); ret_mfma((const bf16*)(ws + WS_Q), (const bf16*)(ws + WS_K), (bf16*)(ws + WS_RV), (float*)(ws + WS_RSTAT), lds, tid, vid, G); }
    xcd_barrier(bar);
    { FRESH_IDS(); WS_LOCAL(); ognorm_phase((const bf16*)(ws + WS_RV), (const bf16*)(ws + WS_G), (const float*)(ws + WS_RSTAT), (signed char*)(ws + WS_Q), SA, gw, NGW, lane); }
    xcd_barrier(bar);
    { WS_LOCAL(); pg8::Gemm g{(const bf16*)(ws + WS_Q), (const bf16*)(ws + WS_W_RET_OUT), RH * RDV}; pg8::StaticOrder S; S.init(M / 256, D / 256, G, vid, nullptr, nullptr);
      pg8::EpiDelta E{(bf16*)(ws + WS_DELTA), MOD1 + 2 * D, SA, SW + SW_RO};
      pg8::gemm_phase<pg8::EpiDelta, pg8::StaticOrder, true, false, true>(lds, g, S, E, FRESH_TID()); }
    xcd_barrier(bar);
    { FRESH_IDS(); WS_LOCAL(); route_phase((bf16*)(ws + WS_X16), (const bf16*)(ws + WS_DELTA), ((const float*)karg(6)) + D, MOD1 + 3 * D, MOD1 + 4 * D, (const float*)karg(17), (const float*)karg(18), XN, SA, (v4u*)(ws + WS_ROUTE), (int*)(ws + WS_RTAB), lds, tid, lane, wave, bid, G); }
    xcd_barrier(bar);
    { FRESH_IDS(); WS_LOCAL(); sort_phase((const v4u*)(ws + WS_ROUTE), (const int*)(ws + WS_RTAB), SA, ws + WS_LIST, lds, tid, bid, G); }
    xcd_barrier(bar);
    { WS_LOCAL(); const int* idx = (const int*)(ws + WS_LIST + LIST_IDX); const int* tile_e = (const int*)(ws + WS_LIST + LIST_TE); const int ntl = __builtin_amdgcn_readfirstlane(*(const int*)(ws + WS_LIST + LIST_NT));
      pg8::Gemm g{(const bf16*)XN, (const bf16*)(ws + WS_W_MOE_GU), D}; pg8::StaticOrder S; S.init(ntl, 2 * FF / 256, G, vid, tile_e, idx);
      pg8::EpiSwigluF8 E{(unsigned char*)(ws + WS_ACT), FF, (const float*)(ws + WS_LIST + LIST_SAL), SW + SW_MOE};
      pg8::gemm_phase<pg8::EpiSwigluF8, pg8::StaticOrder, true, true, true>(lds, g, S, E, FRESH_TID()); }
    xcd_barrier(bar);
    { WS_LOCAL(); const int* idx = (const int*)(ws + WS_LIST + LIST_IDX); const float* gwt = (const float*)(ws + WS_LIST + LIST_GW); const int* tile_e = (const int*)(ws + WS_LIST + LIST_TE); const int ntl = __builtin_amdgcn_readfirstlane(*(const int*)(ws + WS_LIST + LIST_NT));
      pg8::Gemm g{(const bf16*)(ws + WS_ACT), (const bf16*)(ws + WS_W_MOE_DN), FF}; pg8::StaticOrder S; S.init(ntl, D / 256, G, vid, tile_e, nullptr);
      pg8::EpiMoeDown E{(bf16*)(ws + WS_P0), ((long long)WS_P1 - (long long)WS_P0) / 2, idx, gwt, SW + SW_MD, 1.0f / pg8::ACT_F8};
      pg8::gemm_phase<pg8::EpiMoeDown, pg8::StaticOrder, true, false, false, true>(lds, g, S, E, FRESH_TID()); }
    xcd_barrier(bar);
    { FRESH_IDS(); WS_LOCAL(); final_phase(X, (const bf16*)(ws + WS_X16), (const bf16*)(ws + WS_P0), (const bf16*)(ws + WS_P1), (const float*)karg(21), MOD1 + 5 * D, gw, NGW, lane); }
}

extern "C" void kernel_launch(void* const* d_in, const int* in_sizes, int n_in, void* d_out, int out_size, void* d_ws, size_t ws_size, hipStream_t stream) {
    static int grid = 0;
    if (grid == 0) {
        if (n_in != 22 || in_sizes[0] != M * D || out_size != M * D || ws_size < WS_END) { fprintf(stderr, "kernel_launch: unexpected shapes (n_in %d, in0 %d, out %d, ws %zu < %zu)\n", n_in, n_in > 0 ? in_sizes[0] : -1, out_size, ws_size, (size_t)WS_END); grid = -1; return; }
        int dev = 0, cus = 0, per_cu = 0;
        if (hipGetDevice(&dev) != hipSuccess || hipDeviceGetAttribute(&cus, hipDeviceAttributeMultiprocessorCount, dev) != hipSuccess) { grid = -1; return; }
        if (hipFuncSetAttribute((const void*)fwd, hipFuncAttributeMaxDynamicSharedMemorySize, LDS_BYTES) != hipSuccess) { fprintf(stderr, "kernel_launch: hipFuncSetAttribute failed\n"); grid = -1; return; }
        if (hipOccupancyMaxActiveBlocksPerMultiprocessor(&per_cu, (const void*)fwd, 512, LDS_BYTES) != hipSuccess || per_cu < 1) fprintf(stderr, "kernel_launch: occupancy query says %d\n", per_cu);
        (void)hipGetLastError();
        grid = cus;
    }
    if (grid < 0) return;
    if (hipMemsetAsync((char*)d_ws + WS_CTL, 0, CTL_ZERO_BYTES, stream) != hipSuccess) return;
    Args a{};
    for (int i = 0; i < 22; ++i) a.in[i] = d_in[i];
    a.out = (float*)d_out; a.ws = (unsigned char*)d_ws;
    hipLaunchKernelGGL(fwd, dim3(grid), dim3(512), LDS_BYTES, stream, a);
}
```

```cpp
#include <hip/hip_runtime.h>
#include <cstdio>
#include <cstdint>

constexpr int D = 1024, NB = 8, SEQ = 4096, M = NB * SEQ;
constexpr int CH = 128, SGW = 2048, NGRP = 8;
constexpr int RH = 4, RDK = 256, RDV = 512, RET_IN = 6144;
constexpr int FF = 2816, NE = 8;
constexpr float EPS = 1e-6f;
constexpr float U_F8 = 16.0f;
constexpr float UR_F8 = 16.0f;
constexpr float V_F8 = 16.0f;
#ifndef MOE_WGM
#define MOE_WGM 8
#endif
constexpr int MODW = 6 * D;
constexpr int LCAP = 2 * M + NE * 256;
constexpr int LTILES = LCAP / 256;

typedef unsigned short bf16;
#define LAS __attribute__((address_space(3)))
#define GAS __attribute__((address_space(1)))
__device__ __forceinline__ float shx(float v, int k, int lane) { return __builtin_bit_cast(float, __builtin_amdgcn_ds_bpermute((lane ^ k) << 2, __builtin_bit_cast(int, v))); }

__device__ __forceinline__ int fresh_lane() { int l; asm volatile("v_mbcnt_lo_u32_b32 %0, -1, 0\n\tv_mbcnt_hi_u32_b32 %0, -1, %0" : "=v"(l)); return l; }
namespace pg8 {
#define PG8_LAS __attribute__((address_space(3)))
constexpr int EPI_SLOT_OFF = 131072 + 1024;
typedef unsigned short bf16_t;
typedef short bf16x8 __attribute__((ext_vector_type(8)));
typedef float f32x4 __attribute__((ext_vector_type(4)));
typedef unsigned u32x4 __attribute__((ext_vector_type(4)));
typedef unsigned u32x2 __attribute__((ext_vector_type(2)));
constexpr int BM = 256, BK = 64, HALF = 128, HTB = HALF * BK * 2, STAGE_BYTES = 8 * HTB, NXCD = 8, WGM = 4;

__host__ __device__ __forceinline__ int lds_byte(int r, int c) { const int st = (r >> 4) * 2 + (c >> 5), rr = r & 15, cc = c & 31, ob = rr * 64 + cc * 2; return st * 1024 + (ob ^ (((ob >> 9) & 1) << 5)); }
__host__ __device__ __forceinline__ void stage_rc(int b, int& R, int& C) { const int st = b / 1024, sb = b % 1024, swz = sb ^ (((sb >> 9) & 1) << 5); R = (st >> 1) * 16 + swz / 64; C = (st & 1) * 32 + (swz % 64) / 2; }
__host__ __device__ __forceinline__ int perm32(int rho) { const int n = rho >> 4, i = rho & 15; return 8 * (i >> 2) + 4 * n + (i & 3); }

struct Unit { int pm, pn, pb; };
struct Gemm { const bf16_t* A; const bf16_t* Bt; int K; };

struct StaticOrder {
    int nM, nN, nwg, G, c, wgm; const int* tile_e; const int* rowmap;
    __device__ void init(int nM_, int nN_, int G_, int c_, const int* te, const int* rm, int wgm_ = WGM) { nM = nM_; nN = nN_; nwg = nM * nN; G = G_; c = c_; tile_e = te; rowmap = rm; wgm = wgm_; }
    __device__ bool next(int i, Unit& u) const {
        const long L = (long)i * G + c; if (L >= nwg) return false;
        int wgid = (int)L; { const int q = nwg / NXCD, r = nwg % NXCD, xcd = wgid % NXCD, off = wgid / NXCD; wgid = (xcd < r ? xcd * (q + 1) : r * (q + 1) + (xcd - r) * q) + off; }
        const int nig = wgm * nN, gid = wgid / nig, fm = gid * wgm, gsz = (nM - fm) < wgm ? (nM - fm) : wgm;
        u.pm = fm + ((wgid % nig) % gsz); u.pn = (wgid % nig) / gsz;
        u.pb = tile_e ? __builtin_amdgcn_readfirstlane(tile_e[u.pm]) * nN + u.pn : u.pn; return true;
    }
};

__device__ __forceinline__ unsigned cvt_pk_bf16(float lo, float hi) { unsigned r; asm volatile("v_cvt_pk_bf16_f32 %0, %1, %2" : "=v"(r) : "v"(lo), "v"(hi)); return r; }

typedef int i32x4 __attribute__((ext_vector_type(4)));
typedef int i32x8 __attribute__((ext_vector_type(8)));
typedef short bf16x16 __attribute__((ext_vector_type(16)));
#ifndef F8SCALE
#define F8SCALE 0
#endif
template <bool I8> struct AccT { typedef f32x4 type; };
template <> struct AccT<true> { typedef i32x4 type; };
template <class Epi, class Sched, bool ALIGN_EPI, bool GATHER, bool I8 = false, bool F8 = false>
__device__ __forceinline__ void gemm_phase(PG8_LAS unsigned char* lds, const Gemm g, const Sched& S, const Epi& E, int tid_) {
    asm volatile("" : "+v"(tid_));
    const int tid = tid_, wid = __builtin_amdgcn_readfirstlane(tid >> 6), lane = tid & 63, wr = wid >> 2, wc = wid & 3, fr = lane & 15, fq = lane >> 4;
    const int K = (I8 || F8) ? g.K : 2 * g.K  , nt = K / 128;
    int R0, C0; stage_rc(tid * 16, R0, C0); C0 *= 2;
    unsigned voffB[2];
    { const int Rb = Epi::PERM ? ((R0 & ~31) + perm32(R0 & 31)) : R0; voffB[0] = (unsigned)(Rb * K + C0); voffB[1] = voffB[0] + (unsigned)(64 * K); }
    const size_t kstep = (size_t)128;
    const size_t hstep = (size_t)HALF * K;
    const size_t tstep = 2 * hstep;
    const unsigned ldsw = (unsigned)wid * 1024u;
    const int aoff = lds_byte(wr * 64 + fr, fq * 8), boff = lds_byte(wc * 32 + fr, fq * 8);
#define PG8_SA(b, h) (((b) * 2 + (h)) * HTB)
#define PG8_SB(b, h) ((4 + (b) * 2 + (h)) * HTB)
#define PG8_STAGE(bufoff, gbase, voff) do { _Pragma("unroll") for (int _i = 0; _i < 2; ++_i) \
        __builtin_amdgcn_global_load_lds((const unsigned*)((const char*)(gbase) + (voff)[_i]), (PG8_LAS unsigned*)(lds + (bufoff) + ldsw + _i * 8192), 16, 0, 0); } while (0)
#define PG8_LDA(dst, b, h) do { if constexpr (F8) { _Pragma("unroll") for (int m = 0; m < 4; ++m) dst##x[m] = __builtin_shufflevector(*(const PG8_LAS bf16x8*)(lds + PG8_SA(b, h) + aoff + m * 2048), *(const PG8_LAS bf16x8*)(lds + PG8_SA(b, h) + aoff + m * 2048 + 1024), 0, 1, 2, 3, 4, 5, 6, 7, 8, 9, 10, 11, 12, 13, 14, 15); } \
        else { _Pragma("unroll") for (int m = 0; m < 4; ++m) _Pragma("unroll") for (int k = 0; k < 2; ++k) dst[m][k] = *(const PG8_LAS bf16x8*)(lds + PG8_SA(b, h) + aoff + m * 2048 + k * 1024); } } while (0)
#define PG8_LDB(dst, b, h) do { if constexpr (F8) { _Pragma("unroll") for (int n = 0; n < 2; ++n) dst##x[n] = __builtin_shufflevector(*(const PG8_LAS bf16x8*)(lds + PG8_SB(b, h) + boff + n * 2048), *(const PG8_LAS bf16x8*)(lds + PG8_SB(b, h) + boff + n * 2048 + 1024), 0, 1, 2, 3, 4, 5, 6, 7, 8, 9, 10, 11, 12, 13, 14, 15); } \
        else { _Pragma("unroll") for (int n = 0; n < 2; ++n) _Pragma("unroll") for (int k = 0; k < 2; ++k) dst[n][k] = *(const PG8_LAS bf16x8*)(lds + PG8_SB(b, h) + boff + n * 2048 + k * 1024); } } while (0)
#define PG8_MMA(ai, bj, At, Bt) do { __builtin_amdgcn_s_setprio(1); \
        if constexpr (F8) { _Pragma("unroll") for (int m = 0; m < 4; ++m) _Pragma("unroll") for (int n = 0; n < 2; ++n) \
            acc[ai][bj][m][n] = __builtin_amdgcn_mfma_scale_f32_16x16x128_f8f6f4(__builtin_bit_cast(i32x8, Bt##x[n]), __builtin_bit_cast(i32x8, At##x[m]), acc[ai][bj][m][n], 0, 0, 0, F8SCALE, 0, F8SCALE); } \
        else _Pragma("unroll") for (int m = 0; m < 4; ++m) _Pragma("unroll") for (int n = 0; n < 2; ++n) _Pragma("unroll") for (int k = 0; k < 2; ++k) { \
        if constexpr (I8) acc[ai][bj][m][n] = __builtin_amdgcn_mfma_i32_16x16x64_i8(__builtin_bit_cast(i32x4, Bt[n][k]), __builtin_bit_cast(i32x4, At[m][k]), acc[ai][bj][m][n], 0, 0, 0); \
        else acc[ai][bj][m][n] = __builtin_amdgcn_mfma_f32_16x16x32_bf16(Bt[n][k], At[m][k], acc[ai][bj][m][n], 0, 0, 0); } __builtin_amdgcn_s_setprio(0); } while (0)
#define PG8_WAIT_V(n) asm volatile("s_waitcnt vmcnt(" #n ")" ::: "memory")
#define PG8_WAIT_L(n) asm volatile("s_waitcnt lgkmcnt(" #n ")" ::: "memory")
#define PG8_BAR __builtin_amdgcn_s_barrier()
#define PG8_SCHED __builtin_amdgcn_sched_barrier(0)
#define PG8_AOFF(dst, u) do { _Pragma("unroll") for (int _h = 0; _h < 2; ++_h) _Pragma("unroll") for (int _i = 0; _i < 2; ++_i) { \
        int _row = (u).pm * BM + _h * HALF + R0 + 64 * _i; if (GATHER) { const int _t = S.rowmap[_row]; _row = _t < 0 ? 0 : (_t >> 1); } \
        dst[_h][_i] = (unsigned)_row * (unsigned)K + (unsigned)C0; } } while (0)
    Unit cur, nxt; int ui = 0;
    if (!S.next(0, cur)) return;
    cur.pm = __builtin_amdgcn_readfirstlane(cur.pm); cur.pn = __builtin_amdgcn_readfirstlane(cur.pn); cur.pb = __builtin_amdgcn_readfirstlane(cur.pb);
    typedef typename AccT<I8>::type acc_t;
    acc_t acc[2][2][4][2];
#pragma unroll
    for (int a = 0; a < 2; ++a)
#pragma unroll
        for (int b = 0; b < 2; ++b)
#pragma unroll
            for (int m = 0; m < 4; ++m)
#pragma unroll
                for (int n = 0; n < 2; ++n) acc[a][b][m][n] = (acc_t){0, 0, 0, 0};
    bf16x8 At[4][2], B0[2][2], B1[2][2]; bf16x16 Atx[4], B0x[2], B1x[2];
    unsigned oA[2][2]; PG8_AOFF(oA, cur);
    PG8_LAS unsigned char* const eslot = lds + EPI_SLOT_OFF + wid * 768;
    if constexpr (I8 && Epi::RAW) E.pre_dma(cur, wid, wr, wc, lane, eslot);
    const char* Ab = (const char*)g.A; const char* cB = (const char*)g.Bt + (size_t)cur.pb * tstep;
    PG8_STAGE(PG8_SB(0, 0), cB, voffB); PG8_STAGE(PG8_SB(0, 1), cB + hstep, voffB); PG8_STAGE(PG8_SA(0, 0), Ab, oA[0]); PG8_STAGE(PG8_SA(0, 1), Ab, oA[1]);
    if (wr == 1) PG8_BAR;
    PG8_WAIT_V(2); PG8_BAR;
    PG8_STAGE(PG8_SB(1, 0), cB + kstep, voffB); PG8_STAGE(PG8_SA(1, 0), Ab + kstep, oA[0]); PG8_STAGE(PG8_SB(1, 1), cB + hstep + kstep, voffB);
    PG8_WAIT_V(6); PG8_BAR;
    for (;;) {
        const bool has_next = __builtin_amdgcn_readfirstlane((int)S.next(ui + 1, nxt)) != 0;
        nxt.pm = __builtin_amdgcn_readfirstlane(nxt.pm); nxt.pn = __builtin_amdgcn_readfirstlane(nxt.pn); nxt.pb = __builtin_amdgcn_readfirstlane(nxt.pb);
        const char* nB = has_next ? (const char*)g.Bt + (size_t)nxt.pb * tstep : cB;
        for (int t = 0; t < nt; t += 2) {
            const bool last = (t == nt - 2);
            const bool sw = last && has_next;
            const char* a1 = Ab + (size_t)(t + 1) * kstep;
            const char* a2 = last ? Ab : Ab + (size_t)(t + 2) * kstep; const char* b2 = last ? nB : cB + (size_t)(t + 2) * kstep;
            const char* a3 = a2 + kstep; const char* b3 = b2 + kstep;
            unsigned nO[2][2];
            if (sw) { PG8_AOFF(nO, nxt); }
            PG8_LDB(B0, 0, 0); PG8_LDB(B1, 0, 1); PG8_SCHED; PG8_LDA(At, 0, 0); PG8_STAGE(PG8_SA(1, 1), a1, oA[1]);
            PG8_WAIT_V(8); PG8_WAIT_L(0); PG8_BAR; PG8_MMA(0, 0, At, B0); PG8_MMA(0, 1, At, B1); PG8_BAR; PG8_SCHED;
            if (sw) { oA[0][0] = nO[0][0]; oA[0][1] = nO[0][1]; oA[1][0] = nO[1][0]; oA[1][1] = nO[1][1]; }
            PG8_LDA(At, 0, 1); PG8_STAGE(PG8_SB(0, 0), b2, voffB); PG8_STAGE(PG8_SB(0, 1), b2 + hstep, voffB); PG8_STAGE(PG8_SA(0, 0), a2, oA[0]);
            PG8_WAIT_V(8); PG8_WAIT_L(0); PG8_BAR; PG8_MMA(1, 0, At, B0); PG8_MMA(1, 1, At, B1); PG8_BAR; PG8_SCHED;
            PG8_LDB(B0, 1, 0); PG8_LDB(B1, 1, 1); PG8_SCHED; PG8_LDA(At, 1, 0); PG8_STAGE(PG8_SA(0, 1), a2, oA[1]);
            PG8_WAIT_V(8); PG8_WAIT_L(0); PG8_BAR; PG8_MMA(0, 0, At, B0); PG8_MMA(0, 1, At, B1); PG8_BAR; PG8_SCHED;
            PG8_LDA(At, 1, 1); PG8_STAGE(PG8_SB(1, 0), b3, voffB); PG8_STAGE(PG8_SB(1, 1), b3 + hstep, voffB); PG8_STAGE(PG8_SA(1, 0), a3, oA[0]);
            PG8_WAIT_V(8); PG8_WAIT_L(0); PG8_BAR; PG8_MMA(1, 0, At, B0); PG8_MMA(1, 1, At, B1); PG8_BAR; PG8_SCHED;
        }
        if constexpr (ALIGN_EPI) { if (wr == 0) PG8_BAR; }
        if constexpr (F8) {
            { const int le_ = fresh_lane(); E(acc, cur, wr, wc, le_ & 15, le_ >> 4); }
        } else if constexpr (I8) {
            static_assert(!I8 || Epi::PERM, "int8 dequant assumes the PERM column layout");
            if constexpr (Epi::RAW) {
                float csa[2][4]; f32x4 csw[2][2];
                E.pre_read(eslot, fr, fq, csa, csw); PG8_WAIT_L(0);
                { Unit pu; pu.pm = has_next ? nxt.pm : cur.pm; pu.pn = has_next ? nxt.pn : cur.pn; pu.pb = has_next ? nxt.pb : cur.pb; E.pre_dma(pu, wid, wr, wc, lane, eslot); }
                E.raw(acc, cur, wr, wc, fr, fq, csa, csw); } else {
            f32x4 accf[2][2][4][2]; f32x4 swv[2][2];
            const float* swp = E.sw + (size_t)cur.pb * BM + wc * 32 + 8 * fq;
#pragma unroll
            for (int bj = 0; bj < 2; ++bj)
#pragma unroll
                for (int n = 0; n < 2; ++n) swv[bj][n] = *(const f32x4*)(swp + bj * HALF + 4 * n);
#pragma unroll
            for (int ai = 0; ai < 2; ++ai)
#pragma unroll
                for (int m = 0; m < 4; ++m) { int row = cur.pm * BM + ai * HALF + wr * 64 + m * 16 + fr; if (GATHER) { const int t_ = S.rowmap[row]; row = t_ < 0 ? 0 : (t_ >> 1); } const float sa = E.sa[row];
#pragma unroll
                    for (int bj = 0; bj < 2; ++bj)
#pragma unroll
                        for (int n = 0; n < 2; ++n)
#pragma unroll
                            for (int e = 0; e < 4; ++e) accf[ai][bj][m][n][e] = (float)acc[ai][bj][m][n][e] * (sa * swv[bj][n][e]); }
            E(accf, cur, wr, wc, fr, fq); }
        } else {
            E(acc, cur, wr, wc, fr, fq);
        }
        if (!has_next) break;
#pragma unroll
        for (int a = 0; a < 2; ++a)
#pragma unroll
            for (int b = 0; b < 2; ++b)
#pragma unroll
                for (int m = 0; m < 4; ++m)
#pragma unroll
                    for (int n = 0; n < 2; ++n) acc[a][b][m][n] = (acc_t){0, 0, 0, 0};
        cur = nxt; cB = nB; ++ui;
        if constexpr (ALIGN_EPI) { if (wr == 1) PG8_BAR; }
    }
    PG8_WAIT_V(0);
    if constexpr (!ALIGN_EPI) { if (wr == 0) PG8_BAR; }
    PG8_BAR;
#undef PG8_SA
#undef PG8_SB
#undef PG8_STAGE
#undef PG8_LDA
#undef PG8_LDB
#undef PG8_MMA
#undef PG8_WAIT_V
#undef PG8_WAIT_L
#undef PG8_BAR
#undef PG8_SCHED
#undef PG8_AOFF
}

__device__ __forceinline__ float silu_f(float x) { return x * __builtin_amdgcn_rcpf(1.0f + __builtin_amdgcn_exp2f(-1.44269504f * x)); }
__device__ __forceinline__ float gelu_f(float x) { const float t = x * x; const float a = x * (2.30220819f + 0.10294324f * t); return x * __builtin_amdgcn_rcpf(1.0f + __builtin_amdgcn_exp2f(-a)); }

__device__ __forceinline__ unsigned pk4_fp8(float a, float b, float c, float d);
struct EpiSguIn {
    static constexpr bool PERM = true; static constexpr bool RAW = false;
    unsigned char* U; unsigned char* V; float2* vstat; const float* sa; const float* sw;
    __device__ __forceinline__ void operator()(const f32x4 (&acc)[2][2][4][2], const Unit& u, int wr, int wc, int fr, int fq) const {
        const int row0 = u.pm * BM + wr * 64 + fr; const bool isV = u.pn >= 8;
        const int col0 = (u.pn & 7) * BM + wc * 32 + 8 * fq;
#pragma unroll
        for (int ai = 0; ai < 2; ++ai)
#pragma unroll
            for (int m = 0; m < 4; ++m) { const int row = row0 + ai * HALF + m * 16; float s = 0.f, q = 0.f;
#pragma unroll
                for (int bj = 0; bj < 2; ++bj) { f32x4 v0 = acc[ai][bj][m][0], v1 = acc[ai][bj][m][1];
                    if (isV) {
#pragma unroll
                        for (int e = 0; e < 4; ++e) { v0[e] = gelu_f(v0[e]); v1[e] = gelu_f(v1[e]); s += v0[e] + v1[e]; q += v0[e] * v0[e] + v1[e] * v1[e]; }
                        u32x2 w8; w8.x = pk4_fp8(v0[0] * V_F8, v0[1] * V_F8, v0[2] * V_F8, v0[3] * V_F8); w8.y = pk4_fp8(v1[0] * V_F8, v1[1] * V_F8, v1[2] * V_F8, v1[3] * V_F8);
                        *(u32x2*)(V + (size_t)row * SGW + col0 + bj * HALF) = w8;
                    } else {
                        u32x2 w8; w8.x = pk4_fp8(v0[0] * UR_F8, v0[1] * UR_F8, v0[2] * UR_F8, v0[3] * UR_F8); w8.y = pk4_fp8(v1[0] * UR_F8, v1[1] * UR_F8, v1[2] * UR_F8, v1[3] * UR_F8);
                        *(u32x2*)(U + (size_t)row * SGW + col0 + bj * HALF) = w8; } }
                if (isV) { const int ln = fq * 16 + fr; s += shx(s, 16, ln); s += shx(s, 32, ln); q += shx(q, 16, ln); q += shx(q, 32, ln);
                    if (fq == 0) vstat[(size_t)row * 32 + (u.pn - 8) * 4 + wc] = make_float2(s, q); } }
    }
};
struct EpiDelta {
    static constexpr bool PERM = true; static constexpr bool RAW = false;
    bf16_t* out; const float* gate; const float* sa; const float* sw;
    __device__ __forceinline__ void operator()(const f32x4 (&acc)[2][2][4][2], const Unit& u, int wr, int wc, int fr, int fq) const {
        const int row0 = u.pm * BM + wr * 64 + fr, col0 = u.pn * BM + wc * 32 + 8 * fq; const int b = (u.pm * BM) / SEQ;
        f32x4 gv[2][2];
#pragma unroll
        for (int bj = 0; bj < 2; ++bj)
#pragma unroll
            for (int n = 0; n < 2; ++n) gv[bj][n] = *(const f32x4*)(gate + (size_t)b * MODW + col0 + bj * HALF + 4 * n);
#pragma unroll
        for (int ai = 0; ai < 2; ++ai)
#pragma unroll
            for (int m = 0; m < 4; ++m) { bf16_t* rowp = out + (size_t)(row0 + ai * HALF + m * 16) * D + col0;
#pragma unroll
                for (int bj = 0; bj < 2; ++bj) { const f32x4 a0 = acc[ai][bj][m][0] * gv[bj][0], a1 = acc[ai][bj][m][1] * gv[bj][1];
                    u32x4 o; o.x = cvt_pk_bf16(a0[0], a0[1]); o.y = cvt_pk_bf16(a0[2], a0[3]); o.z = cvt_pk_bf16(a1[0], a1[1]); o.w = cvt_pk_bf16(a1[2], a1[3]); *(u32x4*)(rowp + bj * HALF) = o; } }
    }
};
struct EpiDeltaF8 {
    static constexpr bool PERM = true; static constexpr bool RAW = false;
    bf16_t* out; const float* gate; const float* sw; float f8s;
    __device__ __forceinline__ void operator()(const f32x4 (&acc)[2][2][4][2], const Unit& u, int wr, int wc, int fr, int fq) const {
        const int row0 = u.pm * BM + wr * 64 + fr, col0 = u.pn * BM + wc * 32 + 8 * fq; const int b = (u.pm * BM) / SEQ;
#pragma unroll
        for (int bj = 0; bj < 2; ++bj) { const float* gp = gate + (size_t)b * MODW + col0 + bj * HALF; const float* sp = sw + (size_t)u.pb * BM + wc * 32 + 8 * fq + bj * HALF;
            const f32x4 g0 = *(const f32x4*)gp * *(const f32x4*)sp * f8s, g1 = *(const f32x4*)(gp + 4) * *(const f32x4*)(sp + 4) * f8s;
#pragma unroll
            for (int ai = 0; ai < 2; ++ai)
#pragma unroll
                for (int m = 0; m < 4; ++m) { bf16_t* rowp = out + (size_t)(row0 + ai * HALF + m * 16) * D + col0 + bj * HALF; const f32x4 a0 = acc[ai][bj][m][0] * g0, a1 = acc[ai][bj][m][1] * g1;
                    u32x4 o; o.x = cvt_pk_bf16(a0[0], a0[1]); o.y = cvt_pk_bf16(a0[2], a0[3]); o.z = cvt_pk_bf16(a1[0], a1[1]); o.w = cvt_pk_bf16(a1[2], a1[3]); *(u32x4*)rowp = o; } }
    }
};
struct EpiSwiglu {
    static constexpr bool PERM = true; static constexpr bool RAW = false;
    bf16_t* O; int ldc; const float* sa; const float* sw;
    __device__ __forceinline__ void operator()(const f32x4 (&acc)[2][2][4][2], const Unit& u, int wr, int wc, int fr, int fq) const {
        const int row0 = u.pm * BM + wr * 64 + fr, col0 = u.pn * HALF + wc * 32 + 8 * fq;
#pragma unroll
        for (int ai = 0; ai < 2; ++ai)
#pragma unroll
            for (int m = 0; m < 4; ++m) { bf16_t* rowp = O + (size_t)(row0 + ai * HALF + m * 16) * ldc + col0;
                f32x4 v0, v1;
#pragma unroll
                for (int e = 0; e < 4; ++e) { v0[e] = silu_f(acc[ai][0][m][0][e]) * acc[ai][1][m][0][e]; v1[e] = silu_f(acc[ai][0][m][1][e]) * acc[ai][1][m][1][e]; }
                u32x4 w; w.x = cvt_pk_bf16(v0[0], v0[1]); w.y = cvt_pk_bf16(v0[2], v0[3]); w.z = cvt_pk_bf16(v1[0], v1[1]); w.w = cvt_pk_bf16(v1[2], v1[3]);
                *(u32x4*)rowp = w; }
    }
};
constexpr float ACT_F8 = 4.0f;
__device__ __forceinline__ unsigned pk4_fp8(float a, float b, float c, float d) {
    a = __builtin_fminf(__builtin_fmaxf(a, -448.f), 448.f); b = __builtin_fminf(__builtin_fmaxf(b, -448.f), 448.f); c = __builtin_fminf(__builtin_fmaxf(c, -448.f), 448.f); d = __builtin_fminf(__builtin_fmaxf(d, -448.f), 448.f);
    unsigned w = 0u; w = __builtin_amdgcn_cvt_pk_fp8_f32(a, b, w, false); w = __builtin_amdgcn_cvt_pk_fp8_f32(c, d, w, true); return w; }
struct EpiSwigluF8 {
    static constexpr bool PERM = true; static constexpr bool RAW = true;
    unsigned char* O; int ldc; const float* sa; const float* sw;
    __device__ __forceinline__ void pre_dma(const Unit& u, int wid, int wr, int wc, int lane, PG8_LAS unsigned char* slot) const {
        const float* sap = sa + u.pm * BM + wr * 64 + lane; const float* swp = sw + (size_t)u.pb * BM + wc * 32 + (lane & 31) + (lane >> 5) * HALF;
        __builtin_amdgcn_global_load_lds((const unsigned*)sap, (PG8_LAS unsigned*)slot, 4, 0, 0);
        __builtin_amdgcn_global_load_lds((const unsigned*)(sap + HALF), (PG8_LAS unsigned*)(slot + 256), 4, 0, 0);
        __builtin_amdgcn_global_load_lds((const unsigned*)swp, (PG8_LAS unsigned*)(slot + 512), 4, 0, 0);
        (void)wid;
    }
    __device__ __forceinline__ void pre_read(PG8_LAS unsigned char* slot, int fr, int fq, float (&psa)[2][4], f32x4 (&psw)[2][2]) const {
        const PG8_LAS float* rp = (const PG8_LAS float*)slot;
#pragma unroll
        for (int ai = 0; ai < 2; ++ai)
#pragma unroll
            for (int m = 0; m < 4; ++m) psa[ai][m] = rp[ai * 64 + m * 16 + fr];
#pragma unroll
        for (int n = 0; n < 2; ++n) { psw[0][n] = *(const PG8_LAS f32x4*)(rp + 128 + 8 * fq + 4 * n); psw[1][n] = *(const PG8_LAS f32x4*)(rp + 160 + 8 * fq + 4 * n); }
    }
    __device__ __forceinline__ void raw(const i32x4 (&acc)[2][2][4][2], const Unit& u, int wr, int wc, int fr, int fq, const float (&sav)[2][4], const f32x4 (&swv)[2][2]) const {
        const int row0 = u.pm * BM + wr * 64 + fr, col0 = u.pn * HALF + wc * 32 + 8 * fq;
        f32x4 cg[2], cw[2];
#pragma unroll
        for (int n = 0; n < 2; ++n) { const f32x4 sg = swv[0][n], su = swv[1][n];
#pragma unroll
            for (int e = 0; e < 4; ++e) { cg[n][e] = -1.44269504f * sg[e]; cw[n][e] = sg[e] * su[e] * ACT_F8; } }
#pragma unroll
        for (int ai = 0; ai < 2; ++ai)
#pragma unroll
            for (int m = 0; m < 4; ++m) { const int row = row0 + ai * HALF + m * 16;
                const float sa_ = sav[ai][m]; unsigned char* rowp = O + (size_t)row * ldc + col0;
                f32x4 v[2];
#pragma unroll
                for (int n = 0; n < 2; ++n)
#pragma unroll
                    for (int e = 0; e < 4; ++e) { const float gs = (float)acc[ai][0][m][n][e] * sa_; const float uf = (float)acc[ai][1][m][n][e];
                        const float r = __builtin_amdgcn_rcpf(1.0f + __builtin_amdgcn_exp2f(gs * cg[n][e]));
                        v[n][e] = (gs * uf) * (cw[n][e] * sa_) * r; }
                u32x2 w; w.x = pk4_fp8(v[0][0], v[0][1], v[0][2], v[0][3]); w.y = pk4_fp8(v[1][0], v[1][1], v[1][2], v[1][3]);
                *(u32x2*)rowp = w; }
    }
    __device__ __forceinline__ void operator()(const f32x4 (&acc)[2][2][4][2], const Unit& u, int wr, int wc, int fr, int fq) const {
        const int row0 = u.pm * BM + wr * 64 + fr, col0 = u.pn * HALF + wc * 32 + 8 * fq;
#pragma unroll
        for (int ai = 0; ai < 2; ++ai)
#pragma unroll
            for (int m = 0; m < 4; ++m) { unsigned char* rowp = O + (size_t)(row0 + ai * HALF + m * 16) * ldc + col0;
                f32x4 v0, v1;
#pragma unroll
                for (int e = 0; e < 4; ++e) { v0[e] = silu_f(acc[ai][0][m][0][e]) * acc[ai][1][m][0][e] * ACT_F8; v1[e] = silu_f(acc[ai][0][m][1][e]) * acc[ai][1][m][1][e] * ACT_F8; }
                u32x2 w; w.x = pk4_fp8(v0[0], v0[1], v0[2], v0[3]); w.y = pk4_fp8(v1[0], v1[1], v1[2], v1[3]);
                *(u32x2*)rowp = w; }
    }
};
struct EpiRetIn {
    static constexpr bool PERM = true; static constexpr bool RAW = false;
    bf16_t *Q, *Kb, *V, *Gs; const int* pos; const float* sa; const float* sw;
    __device__ __forceinline__ void operator()(const f32x4 (&acc)[2][2][4][2], const Unit& u, int wr, int wc, int fr, int fq) const {
        const int row0 = u.pm * BM + wr * 64 + fr; const int pn = u.pn;
        if (pn < 8) {
            bf16_t* base = (pn < 4 ? Q : Kb) + (pn & 3) * RDK + wc * 32 + 8 * fq;
            const float lg2 = __builtin_amdgcn_logf(1.0f - __builtin_amdgcn_exp2f(-5.0f - (float)(pn & 3))) * (pn < 4 ? 1.0f : -1.0f); const float sc0 = pn < 4 ? 1.0f : 0.0625f;
            float invf[2][4];
#pragma unroll
            for (int n = 0; n < 2; ++n)
#pragma unroll
                for (int e = 0; e < 4; ++e) invf[n][e] = __builtin_amdgcn_exp2f(-(float)(32 * wc + 8 * fq + 4 * n + e) * 0.10381025296f) * 0.15915494309f;
            int posv[2][4];
#pragma unroll
            for (int ai = 0; ai < 2; ++ai)
#pragma unroll
                for (int m = 0; m < 4; ++m) posv[ai][m] = pos[row0 + ai * HALF + m * 16];
#pragma unroll
            for (int ai = 0; ai < 2; ++ai)
#pragma unroll
                for (int m = 0; m < 4; ++m) { const int row = row0 + ai * HALF + m * 16; const float p = (float)posv[ai][m]; bf16_t* rowp = base + (size_t)row * D; const float scale = sc0 * __builtin_amdgcn_exp2f((float)(row & 127) * lg2);
                    float o1[2][4], o2[2][4];
#pragma unroll
                    for (int n = 0; n < 2; ++n)
#pragma unroll
                        for (int e = 0; e < 4; ++e) { float r = p * invf[n][e]; r = __builtin_amdgcn_fractf(r); const float sn = __builtin_amdgcn_sinf(r), cs = __builtin_amdgcn_cosf(r);
                            const float t1 = acc[ai][0][m][n][e], t2 = acc[ai][1][m][n][e]; o1[n][e] = (t1 * cs - t2 * sn) * scale; o2[n][e] = (t2 * cs + t1 * sn) * scale; }
                    u32x4 w1, w2; w1.x = cvt_pk_bf16(o1[0][0], o1[0][1]); w1.y = cvt_pk_bf16(o1[0][2], o1[0][3]); w1.z = cvt_pk_bf16(o1[1][0], o1[1][1]); w1.w = cvt_pk_bf16(o1[1][2], o1[1][3]);
                    w2.x = cvt_pk_bf16(o2[0][0], o2[0][1]); w2.y = cvt_pk_bf16(o2[0][2], o2[0][3]); w2.z = cvt_pk_bf16(o2[1][0], o2[1][1]); w2.w = cvt_pk_bf16(o2[1][2], o2[1][3]);
                    *(u32x4*)rowp = w1; *(u32x4*)(rowp + HALF) = w2; }
        } else {
            const bool isG = pn >= 16; bf16_t* base = (isG ? Gs : V) + ((pn - 8) & 7) * BM + wc * 32 + 8 * fq;
#pragma unroll
            for (int ai = 0; ai < 2; ++ai)
#pragma unroll
                for (int m = 0; m < 4; ++m) { bf16_t* rowp = base + (size_t)(row0 + ai * HALF + m * 16) * (RH * RDV);
#pragma unroll
                    for (int bj = 0; bj < 2; ++bj) { f32x4 v0 = acc[ai][bj][m][0], v1 = acc[ai][bj][m][1];
                        u32x4 w; w.x = cvt_pk_bf16(v0[0], v0[1]); w.y = cvt_pk_bf16(v0[2], v0[3]); w.z = cvt_pk_bf16(v1[0], v1[1]); w.w = cvt_pk_bf16(v1[2], v1[3]);
                        *(u32x4*)(rowp + bj * HALF) = w; } }
        }
    }
};
struct EpiMoeDown {
    static constexpr bool PERM = true; static constexpr bool RAW = false;
    bf16_t* P0; long long dP;     const int* idx; const float* gw; const float* sw; float f8s;
    __device__ __forceinline__ void operator()(const f32x4 (&acc)[2][2][4][2], const Unit& u, int wr, int wc, int fr, int fq) const {
        const int row0 = u.pm * BM + wr * 64 + fr, col0 = u.pn * BM + wc * 32 + 8 * fq;
        int vv[2][4]; float ww[2][4];
#pragma unroll
        for (int ai = 0; ai < 2; ++ai)
#pragma unroll
            for (int m = 0; m < 4; ++m) { const int r = row0 + ai * HALF + m * 16; vv[ai][m] = idx[r]; ww[ai][m] = gw[r]; }
        f32x4 sc[2][2];
#pragma unroll
        for (int bj = 0; bj < 2; ++bj) { const float* sp = sw + (size_t)u.pb * BM + wc * 32 + 8 * fq + bj * HALF; sc[bj][0] = *(const f32x4*)sp * f8s; sc[bj][1] = *(const f32x4*)(sp + 4) * f8s; }
#pragma unroll
        for (int ai = 0; ai < 2; ++ai)
#pragma unroll
            for (int m = 0; m < 4; ++m) { const int v = vv[ai][m];
                if (v >= 0) { const int tok = v >> 1; const float w = ww[ai][m]; bf16_t* xp = P0 + (long long)(v & 1) * dP + (size_t)tok * D + col0;
#pragma unroll
                    for (int bj = 0; bj < 2; ++bj) { const f32x4 a0 = acc[ai][bj][m][0] * sc[bj][0] * w, a1 = acc[ai][bj][m][1] * sc[bj][1] * w;
                        u32x4 o; o.x = cvt_pk_bf16(a0[0], a0[1]); o.y = cvt_pk_bf16(a0[2], a0[3]); o.z = cvt_pk_bf16(a1[0], a1[1]); o.w = cvt_pk_bf16(a1[2], a1[3]); *(u32x4*)(xp + bj * HALF) = o; } } }
    }
};
}

constexpr size_t MiB = 1u << 20;
constexpr size_t WS_CTL = 0, CTL_ZERO_BYTES = 1 * MiB;
constexpr size_t WS_MOD = 1 * MiB;
constexpr size_t WS_VSTAT = 2 * MiB;
constexpr size_t WS_RSTAT = 10 * MiB;
constexpr size_t WS_X16 = 16 * MiB;
constexpr size_t WS_W_SGU_IN = 80 * MiB, WS_W_SGU_OUT = 84 * MiB, WS_W_FFN_GU = 88 * MiB, WS_W_FFN_DN = 94 * MiB, WS_W_RET_IN = 100 * MiB, WS_W_RET_OUT = 106 * MiB;
constexpr size_t WS_W_MOE_GU = 110 * MiB, WS_W_MOE_DN = 154 * MiB;
constexpr size_t WS_XN = 198 * MiB;
constexpr size_t WS_P0 = WS_XN;
constexpr size_t WS_R1 = 262 * MiB;
constexpr size_t WS_U8 = WS_R1 + 320 * MiB;
constexpr size_t WS_U = WS_R1, WS_V = WS_R1 + 128 * MiB;
constexpr size_t WS_DELTA = WS_R1 + 256 * MiB;
constexpr size_t WS_ACT = WS_R1;
constexpr size_t WS_Q = WS_R1, WS_K = WS_R1 + 64 * MiB, WS_RV = WS_R1 + 128 * MiB, WS_G = WS_R1 + 256 * MiB;
constexpr size_t WS_P1 = WS_R1 + 363 * MiB;
constexpr size_t WS_SMALL = WS_P1 + 64 * MiB;
constexpr size_t WS_ROUTE = WS_SMALL;
constexpr size_t WS_RTAB = WS_SMALL + 768 * 1024;
constexpr size_t WS_LIST = WS_SMALL + 1 * MiB;
constexpr size_t WS_SA = WS_SMALL + 2 * MiB;
constexpr size_t WS_SW = WS_SMALL + 3 * MiB;
constexpr int SW_SGU = 0, SW_FFN = 2 * SGW, SW_RET = SW_FFN + 2 * FF, SW_MOE = SW_RET + RET_IN, SW_RO = SW_MOE + NE * 2 * FF, SW_MD = SW_RO + D, SW_FD = SW_MD + NE * D, SW_SO = SW_FD + D, NSW = SW_SO + D;
constexpr size_t CTL_COLMAX = 512 * 1024;
constexpr size_t LIST_IDX = 0, LIST_GW = (size_t)LCAP * 4, LIST_TE = LIST_GW + (size_t)LCAP * 4, LIST_NT = LIST_TE + (size_t)LTILES * 4, LIST_SAL = LIST_NT + 64;
constexpr size_t WS_END = WS_SMALL + 4 * MiB;
static_assert(WS_W_FFN_DN + (size_t)D * FF * 2 <= WS_W_RET_IN && WS_W_FFN_GU + (size_t)2 * FF * D <= WS_W_FFN_DN && WS_W_RET_IN + (size_t)RET_IN * D <= WS_W_RET_OUT && WS_W_MOE_GU + (size_t)NE * 2 * FF * D <= WS_W_MOE_DN && WS_W_MOE_DN + (size_t)NE * FF * D * 2 <= WS_XN, "weight map");
static_assert(WS_LIST + LIST_SAL + (size_t)LCAP * 4 <= WS_SA && WS_SW + (size_t)NSW * 4 <= WS_END && (size_t)LCAP * FF * 2 <= 363 * MiB && WS_X16 + (size_t)M * D * 2 <= WS_W_SGU_IN && WS_END <= 700 * MiB, "map");
constexpr int CW_BAR = 4096;

constexpr int RING_BYTES = 131072, LDSCTL_OFF = RING_BYTES, MISC_OFF = LDSCTL_OFF + 320, EXTRA_OFF = RING_BYTES + 1024, LDS_BYTES = 147456;

typedef float f32x4 __attribute__((ext_vector_type(4)));
typedef unsigned v4u __attribute__((ext_vector_type(4)));
typedef unsigned v2u __attribute__((ext_vector_type(2)));
#define LDS_WAIT() asm volatile("s_waitcnt lgkmcnt(0)" ::: "memory")
__device__ __forceinline__ unsigned f2bf(float f) { unsigned u = __builtin_bit_cast(unsigned, f); return (u + 0x7fffu + ((u >> 16) & 1u)) >> 16; }
__device__ __forceinline__ unsigned pk2(float lo, float hi) { return f2bf(lo) | (f2bf(hi) << 16); }
__device__ __forceinline__ float u2f(unsigned w) { return __builtin_bit_cast(float, w); }
__device__ __forceinline__ float bflo(unsigned w) { return __builtin_bit_cast(float, w << 16); }
__device__ __forceinline__ float bfhi(unsigned w) { return __builtin_bit_cast(float, w & 0xffff0000u); }
__device__ __forceinline__ float bf2f(bf16 b) { return __builtin_bit_cast(float, (unsigned)b << 16); }
template <int CTRL> __device__ __forceinline__ float dpp_f(float v) { return __builtin_bit_cast(float, __builtin_amdgcn_update_dpp(0, __builtin_bit_cast(int, v), CTRL, 0xf, 0xf, true)); }
__device__ __forceinline__ float rdl_f(float v, int l) { return __builtin_bit_cast(float, __builtin_amdgcn_readlane(__builtin_bit_cast(int, v), l)); }
__device__ __forceinline__ float wave_sum(float v, int lane) {
    (void)lane;
    v += dpp_f<0xB1>(v); v += dpp_f<0x4E>(v); v += dpp_f<0x141>(v); v += dpp_f<0x140>(v);
    return (rdl_f(v, 0) + rdl_f(v, 16)) + (rdl_f(v, 32) + rdl_f(v, 48));
}

#define XB_TMO      128
#define XB_XCNT(j)  (256  + 64 * (j))
#define XB_XSUB(j)  (1280 + 64 * (j))
#define XB_XGEN(j)  (2304 + 64 * (j))
#define XB_TOP      3328
#define XB_TOPGEN   3392
#define XCD_BAR_WORDS 3456
#define XB_SPIN_CAP (1u << 18)
__device__ __forceinline__ unsigned xb_ld(unsigned* p)              { return __hip_atomic_load(p, __ATOMIC_RELAXED, __HIP_MEMORY_SCOPE_AGENT); }
__device__ __forceinline__ unsigned xb_add(unsigned* p, unsigned v) { return __hip_atomic_fetch_add(p, v, __ATOMIC_RELAXED, __HIP_MEMORY_SCOPE_AGENT); }
__device__ __forceinline__ unsigned xb_xcc_id() { return (unsigned)__builtin_amdgcn_s_getreg((3 << 11) | 20) & 0xFu; }
#define XB_SPIN(cond, bar) do { unsigned _sp = 0; while (cond) { __builtin_amdgcn_s_sleep(1); \
    if ((++_sp & 255u) == 0u) { if (xb_ld(&(bar)[XB_TMO])) break; if (_sp > XB_SPIN_CAP) { atomicAdd(&(bar)[XB_TMO], 1u); break; } } } } while (0)
struct XcdBarrier { unsigned* bar; unsigned x; volatile LAS unsigned* st; };
__device__ __forceinline__ XcdBarrier xcd_barrier_post(unsigned* bar, volatile LAS unsigned* st) {
    XcdBarrier b; b.bar = bar; b.x = xb_xcc_id(); b.st = st;
    if (threadIdx.x == 0) st[2] = xb_add(&bar[XB_XCNT(b.x)], 1u);
    return b;
}
__device__ __forceinline__ void xcd_barrier_complete(unsigned* bar, unsigned x, unsigned& nloc, unsigned& nx) {
    const unsigned G = gridDim.x * gridDim.y * gridDim.z;
    unsigned sum, cnt, mine, sp = 0u;
    for (;;) {
        sum = 0u; cnt = 0u; mine = 0u;
#pragma unroll
        for (unsigned j = 0; j < 16; ++j) { const unsigned c = xb_ld(&bar[XB_XCNT(j)]); sum += c; cnt += (c > 0u) ? 1u : 0u; mine = (j == x) ? c : mine; }
        if (sum == G) break;
        __builtin_amdgcn_s_sleep(1);
        if ((++sp & 255u) == 0u) { if (xb_ld(&bar[XB_TMO])) break; if (sp > XB_SPIN_CAP) { atomicAdd(&bar[XB_TMO], 1u); break; } }
    }
    nloc = mine > 0u ? mine : 1u; nx = cnt > 0u ? cnt : 1u;
}
__device__ __forceinline__ void xcd_barrier(const XcdBarrier& b) {
    asm volatile("s_waitcnt vmcnt(0)" ::: "memory");
    __syncthreads();
    if (threadIdx.x == 0) {
        unsigned* bar = b.bar;
        __builtin_amdgcn_s_waitcnt(0);
        unsigned nloc = b.st[0], nx = b.st[1];
        if (nloc == 0u) { xcd_barrier_complete(bar, b.x, nloc, nx); b.st[0] = nloc; b.st[1] = nx; }
        const unsigned old = xb_add(&bar[XB_XSUB(b.x)], 1u);
        const unsigned gen = old / nloc;
        if (old + 1u == (gen + 1u) * nloc) {
            __builtin_amdgcn_fence(__ATOMIC_RELEASE, "agent");
            asm volatile("s_waitcnt vmcnt(0)" ::: "memory");
            const unsigned og = xb_add(&bar[XB_TOP], 1u);
            const unsigned tg = og / nx;
            if (og + 1u == (tg + 1u) * nx) xb_add(&bar[XB_TOPGEN], 1u);
            else XB_SPIN(xb_ld(&bar[XB_TOPGEN]) == tg, bar);
            __builtin_amdgcn_fence(__ATOMIC_ACQUIRE, "agent");
            xb_add(&bar[XB_XGEN(b.x)], 1u);
            asm volatile("s_waitcnt vmcnt(0)" ::: "memory");
        } else {
            XB_SPIN(xb_ld(&bar[XB_XGEN(b.x)]) == gen, bar);
            __builtin_amdgcn_fence(__ATOMIC_ACQUIRE, "agent");
            asm volatile("s_waitcnt vmcnt(0)" ::: "memory");
        }
    }
    __syncthreads();
}

__device__ __forceinline__ void mod_phase(const float* c, const float* ada_w, const float* ada_b, float* MOD, LAS unsigned char* lds, int tid, int lane, int wave, int bid, int G) {
    LAS float* sc = (LAS float*)lds;
    LAS float* red = (LAS float*)(lds + 32768);
    for (int i = tid; i < NB * D; i += 512) { const float v = c[i]; sc[i] = v / (1.0f + __expf(-v)); }
    __syncthreads();
    constexpr int CPI = 64, NITEM = 2 * MODW / CPI;
    static_assert(MODW % CPI == 0, "an item never straddles the two layers");
    for (int it = bid; it < NITEM; it += G) {
        const int col0 = it * CPI, l = col0 / MODW, cl0 = col0 % MODW, c4 = lane & 15, ks = lane >> 4;
        const float* w = ada_w + (size_t)l * D * MODW + (size_t)(wave * 128 + ks) * MODW + cl0 + 4 * c4;
        f32x4 a[NB];
#pragma unroll
        for (int b = 0; b < NB; ++b) a[b] = (f32x4){0.f, 0.f, 0.f, 0.f};
#pragma unroll 8
        for (int i = 0; i < 32; ++i) { const f32x4 wv = *(const f32x4*)(w + (size_t)(4 * i) * MODW); const int k = wave * 128 + 4 * i + ks;
#pragma unroll
            for (int b = 0; b < NB; ++b) a[b] += wv * sc[b * D + k]; }
#pragma unroll
        for (int b = 0; b < NB; ++b) *(LAS f32x4*)(red + ((wave * 4 + ks) * NB + b) * 64 + 4 * c4) = a[b];
        __syncthreads();
        { const int b = tid >> 6; float sum = 0.f;
#pragma unroll 8
            for (int p = 0; p < 32; ++p) sum += red[(p * NB + b) * 64 + lane];
            MOD[(size_t)(l * NB + b) * MODW + cl0 + lane] = sum + ada_b[l * MODW + cl0 + lane]; }
        __syncthreads();
    }
}
template <int MODE>
__device__ __forceinline__ void cvt_item(const float* W, int K, int N, bf16* WT, LAS float* scr, int item, int lane) {
    const int nblk = N / 32, kb = item / nblk, nb = item % nblk, k0 = 64 * kb, n0 = 32 * nb;
    int drow0 = n0;
    if (MODE == 1) { const int half = n0 >= FF ? 1 : 0; const int j = n0 - half * FF; drow0 = (j >> 7) * 256 + half * 128 + (j & 127); }
#pragma unroll 8
    for (int i = 0; i < 32; ++i) { const int kk = 2 * i + (lane >> 5); scr[kk * 33 + (lane & 31)] = W[(size_t)(k0 + kk) * N + n0 + (lane & 31)]; }
    LDS_WAIT(); asm volatile("" ::: "memory");
    const int c = lane & 7;
#pragma unroll
    for (int j = 0; j < 4; ++j) { const int n = (lane >> 3) + 8 * j; const LAS float* s = scr + (8 * c) * 33 + n;
        v4u o; o.x = pk2(s[0 * 33], s[1 * 33]); o.y = pk2(s[2 * 33], s[3 * 33]); o.z = pk2(s[4 * 33], s[5 * 33]); o.w = pk2(s[6 * 33], s[7 * 33]);
        *(v4u*)(WT + (size_t)(drow0 + n) * K + k0 + 8 * c) = o; }
    LDS_WAIT(); asm volatile("" ::: "memory");
}
constexpr int AMK = 32;
template <int MODE>
__device__ __forceinline__ void amax_item(const float* W, int K, int N, unsigned* cmax, int item, int lane) {
    const int nblk = N / 256, kb = item / nblk, nb = item % nblk, k0 = AMK * kb, n0 = 256 * nb + 4 * lane;
    int drow0 = n0;
    if (MODE == 1) { const int half = n0 >= FF ? 1 : 0; const int j = n0 - half * FF; drow0 = (j >> 7) * 256 + half * 128 + (j & 127); }
    f32x4 mx = {0.f, 0.f, 0.f, 0.f};
    const float* wp = W + (size_t)k0 * N + n0;
#pragma unroll 8
    for (int i = 0; i < AMK; ++i) { const f32x4 v = *(const f32x4*)(wp + (size_t)i * N); mx[0] = fmaxf(mx[0], fabsf(v[0])); mx[1] = fmaxf(mx[1], fabsf(v[1])); mx[2] = fmaxf(mx[2], fabsf(v[2])); mx[3] = fmaxf(mx[3], fabsf(v[3])); }
#pragma unroll
    for (int e = 0; e < 4; ++e) atomicMax(cmax + drow0 + e, __builtin_bit_cast(unsigned, (float)mx[e]));
}
template <int MODE>
__device__ __forceinline__ void cvt8_item(const float* W, int K, int N, signed char* WT, const unsigned* cmax, float* sw, LAS float* scr, int item, int lane) {
    const int nblk = N / 32, kb = item / nblk, nb = item % nblk, k0 = 64 * kb, n0 = 32 * nb;
    int drow0 = n0;
    if (MODE == 1) { const int half = n0 >= FF ? 1 : 0; const int j = n0 - half * FF; drow0 = (j >> 7) * 256 + half * 128 + (j & 127); }
#pragma unroll 8
    for (int i = 0; i < 32; ++i) { const int kk = 2 * i + (lane >> 5); scr[kk * 33 + (lane & 31)] = W[(size_t)(k0 + kk) * N + n0 + (lane & 31)]; }
    LDS_WAIT(); asm volatile("" ::: "memory");
    const int c = lane & 7;
#pragma unroll
    for (int j = 0; j < 4; ++j) { const int n = (lane >> 3) + 8 * j; const LAS float* sp = scr + (8 * c) * 33 + n;
        const float am = u2f(cmax[drow0 + n]); const float inv = am > 0.f ? 127.0f / am : 0.f;
        unsigned w0 = 0u, w1 = 0u;
#pragma unroll
        for (int e = 0; e < 4; ++e) { const int q0 = (int)__builtin_rintf(sp[e * 33] * inv), q1 = (int)__builtin_rintf(sp[(4 + e) * 33] * inv); w0 |= ((unsigned)q0 & 0xffu) << (8 * e); w1 |= ((unsigned)q1 & 0xffu) << (8 * e); }
        v2u o; o.x = w0; o.y = w1; *(v2u*)(WT + (size_t)(drow0 + n) * K + k0 + 8 * c) = o;
        if (kb == 0 && c == 0) sw[drow0 + n] = am * (1.0f / 127.0f); }
    LDS_WAIT(); asm volatile("" ::: "memory");
}
__device__ __forceinline__ void cvtf8_item(const float* W, int K, int N, unsigned char* WT, const unsigned* cmax, float* sw, LAS float* scr, int item, int lane) {
    const int nblk = N / 32, kb = item / nblk, nb = item % nblk, k0 = 64 * kb, n0 = 32 * nb;
#pragma unroll 8
    for (int i = 0; i < 32; ++i) { const int kk = 2 * i + (lane >> 5); scr[kk * 33 + (lane & 31)] = W[(size_t)(k0 + kk) * N + n0 + (lane & 31)]; }
    LDS_WAIT(); asm volatile("" ::: "memory");
    const int c = lane & 7;
#pragma unroll
    for (int j = 0; j < 4; ++j) { const int n = (lane >> 3) + 8 * j; const LAS float* sp = scr + (8 * c) * 33 + n;
        const float am = u2f(cmax[n0 + n]); int ex = 0; if (am > 0.f) ex = 7 - ((int)((cmax[n0 + n] >> 23) & 0xffu) - 127);
        ex -= 1; const float sc = __builtin_ldexpf(1.0f, ex);
        v2u o; o.x = pg8::pk4_fp8(sp[0 * 33] * sc, sp[1 * 33] * sc, sp[2 * 33] * sc, sp[3 * 33] * sc); o.y = pg8::pk4_fp8(sp[4 * 33] * sc, sp[5 * 33] * sc, sp[6 * 33] * sc, sp[7 * 33] * sc);
        *(v2u*)(WT + (size_t)(n0 + n) * K + k0 + 8 * c) = o;
        if (kb == 0 && c == 0) sw[n0 + n] = __builtin_ldexpf(1.0f, -ex); }
    LDS_WAIT(); asm volatile("" ::: "memory");
}
template <int MODE, bool F8>
__device__ __forceinline__ void cvtq_tile(const float* W, int K, int N, unsigned char* WT, const unsigned* cmax, float* sw, LAS float* scr, int item, int tid) {
    const int nblk = N / 128, kb = item / nblk, nb = item % nblk, k0 = 128 * kb, n0 = 128 * nb;
    int drow0 = n0;
    if (MODE == 1) { const int half = n0 >= FF ? 1 : 0; const int j = n0 - half * FF; drow0 = (j >> 7) * 256 + half * 128; }
    const int lane = tid & 63, w = tid >> 6;
    { const float* wp = W + (size_t)(k0 + w * 16 + (lane >> 5)) * N + n0 + (lane & 31) * 4;
      f32x4 v[8];
#pragma unroll
      for (int i = 0; i < 8; ++i) v[i] = *(const f32x4*)(wp + (size_t)(2 * i) * N);
#pragma unroll
      for (int i = 0; i < 8; ++i) *(LAS f32x4*)(scr + (w * 16 + 2 * i + (lane >> 5)) * 132 + (lane & 31) * 4) = v[i]; }
    __syncthreads();
    { const int n = tid & 127, kq = tid >> 7;
      const unsigned cm = cmax[drow0 + n]; const float am = u2f(cm);
      float sc, swv;
      if (F8) { int ex = 0; if (am > 0.f) ex = 7 - ((int)((cm >> 23) & 0xffu) - 127); ex -= 1; sc = __builtin_ldexpf(1.0f, ex); swv = __builtin_ldexpf(1.0f, -ex); }
      else { sc = am > 0.f ? 127.0f / am : 0.f; swv = am * (1.0f / 127.0f); }
      const LAS float* sp = scr + (32 * kq) * 132 + n;
      unsigned o[8];
#pragma unroll
      for (int q = 0; q < 8; ++q) { const float a = sp[(4 * q + 0) * 132] * sc, b = sp[(4 * q + 1) * 132] * sc, c = sp[(4 * q + 2) * 132] * sc, d = sp[(4 * q + 3) * 132] * sc;
          if (F8) o[q] = pg8::pk4_fp8(a, b, c, d);
          else o[q] = ((unsigned)(int)__builtin_rintf(a) & 0xffu) | (((unsigned)(int)__builtin_rintf(b) & 0xffu) << 8) | (((unsigned)(int)__builtin_rintf(c) & 0xffu) << 16) | (((unsigned)(int)__builtin_rintf(d) & 0xffu) << 24); }
      v4u* dst = (v4u*)(WT + (size_t)(drow0 + n) * K + k0 + 32 * kq);
      v4u o0, o1; o0.x = o[0]; o0.y = o[1]; o0.z = o[2]; o0.w = o[3]; o1.x = o[4]; o1.y = o[5]; o1.z = o[6]; o1.w = o[7];
      dst[0] = o0; dst[1] = o1;
      if (kb == 0 && kq == 0) sw[drow0 + n] = swv; }
    __syncthreads();
}
struct WPtrs { const float *sgu_in, *sgu_out, *ffn_gu, *ffn_dn, *ret_in, *ret_out, *moe_gu, *moe_dn; };
constexpr int CI0 = (D / 64) * (2 * SGW / 32), CI1 = (SGW / 64) * (D / 32), CI2 = (D / 64) * (2 * FF / 32), CI3 = (FF / 64) * (D / 32), CI4 = (D / 64) * (RET_IN / 32), CI5 = (RH * RDV / 64) * (D / 32);
__device__ __forceinline__ void cvt_phase_a(const WPtrs& P, unsigned char* ws, LAS unsigned char* lds, int gw, int NGW, int wave, int lane) {
    LAS float* scr = (LAS float*)(lds + wave * 16384);
    unsigned* cmax = (unsigned*)(ws + WS_CTL + CTL_COLMAX);
    constexpr int AI1 = (SGW / AMK) * (D / 256), AI0 = (D / AMK) * (2 * SGW / 256), AI2 = (D / AMK) * (2 * FF / 256), AI3 = (FF / AMK) * (D / 256), AI4 = (D / AMK) * (RET_IN / 256), AI5 = (RH * RDV / AMK) * (D / 256);
    static_assert(D % AMK == 0 && FF % AMK == 0 && (RH * RDV) % AMK == 0 && FF % 256 == 0 && (2 * SGW) % 256 == 0 && RET_IN % 256 == 0, "absmax item shape");
    constexpr int NIT = AI1 + AI3 + AI5 + NE * AI3 + AI0 + AI2 + AI4 + NE * AI2;
    for (int it = gw; it < NIT; it += NGW) {
        int r = it;
        if (r < AI1) { amax_item<0>(P.sgu_out, SGW, D, cmax + SW_SO, r, lane); continue; } r -= AI1;
        if (r < AI3) { amax_item<0>(P.ffn_dn, FF, D, cmax + SW_FD, r, lane); continue; } r -= AI3;
        if (r < AI5) { amax_item<0>(P.ret_out, RH * RDV, D, cmax + SW_RO, r, lane); continue; } r -= AI5;
        if (r < NE * AI3) { const int e = r / AI3; amax_item<0>(P.moe_dn + (size_t)e * FF * D, FF, D, cmax + SW_MD + e * D, r % AI3, lane); continue; } r -= NE * AI3;
        if (r < AI0) { amax_item<0>(P.sgu_in, D, 2 * SGW, cmax + SW_SGU, r, lane); continue; } r -= AI0;
        if (r < AI2) { amax_item<1>(P.ffn_gu, D, 2 * FF, cmax + SW_FFN, r, lane); continue; } r -= AI2;
        if (r < AI4) { amax_item<0>(P.ret_in, D, RET_IN, cmax + SW_RET, r, lane); continue; } r -= AI4;
        { const int e = r / AI2; amax_item<1>(P.moe_gu + (size_t)e * D * 2 * FF, D, 2 * FF, cmax + SW_MOE + e * 2 * FF, r % AI2, lane); }
    }
}
__device__ __forceinline__ void cvt_phase_b(const WPtrs& P, unsigned char* ws, LAS unsigned char* lds, int bid, int G, int tid) {
    LAS float* scr = (LAS float*)lds;
    const unsigned* cmax = (const unsigned*)(ws + WS_CTL + CTL_COLMAX); float* sw = (float*)(ws + WS_SW);
    constexpr int T0 = (D / 128) * (2 * SGW / 128), T2 = (D / 128) * (2 * FF / 128), T3 = (FF / 128) * (D / 128), T4 = (D / 128) * (RET_IN / 128), T5 = (RH * RDV / 128) * (D / 128);
    static_assert(FF % 128 == 0 && D % 128 == 0 && RET_IN % 128 == 0 && (2 * SGW) % 128 == 0 && (RH * RDV) % 128 == 0, "pass-B tile shape");
    constexpr int T1 = (SGW / 128) * (D / 128);
    constexpr int NIT = T1 + T3 + NE * T3 + T5 + T0 + T2 + T4 + NE * T2;
    for (int it = bid; it < NIT; it += G) {
        int r = it;
        if (r < T1) { cvtq_tile<0, true>(P.sgu_out, SGW, D, (unsigned char*)(ws + WS_W_SGU_OUT), cmax + SW_SO, sw + SW_SO, scr, r, tid); continue; } r -= T1;
        if (r < T3) { cvtq_tile<0, true>(P.ffn_dn, FF, D, (unsigned char*)(ws + WS_W_FFN_DN), cmax + SW_FD, sw + SW_FD, scr, r, tid); continue; } r -= T3;
        if (r < NE * T3) { const int e = r / T3; cvtq_tile<0, true>(P.moe_dn + (size_t)e * FF * D, FF, D, (unsigned char*)(ws + WS_W_MOE_DN) + (size_t)e * D * FF, cmax + SW_MD + e * D, sw + SW_MD + e * D, scr, r % T3, tid); continue; } r -= NE * T3;
        if (r < T5) { cvtq_tile<0, false>(P.ret_out, RH * RDV, D, (unsigned char*)(ws + WS_W_RET_OUT), cmax + SW_RO, sw + SW_RO, scr, r, tid); continue; } r -= T5;
        if (r < T0) { cvtq_tile<0, false>(P.sgu_in, D, 2 * SGW, (unsigned char*)(ws + WS_W_SGU_IN), cmax + SW_SGU, sw + SW_SGU, scr, r, tid); continue; } r -= T0;
        if (r < T2) { cvtq_tile<1, false>(P.ffn_gu, D, 2 * FF, (unsigned char*)(ws + WS_W_FFN_GU), cmax + SW_FFN, sw + SW_FFN, scr, r, tid); continue; } r -= T2;
        if (r < T4) { cvtq_tile<0, false>(P.ret_in, D, RET_IN, (unsigned char*)(ws + WS_W_RET_IN), cmax + SW_RET, sw + SW_RET, scr, r, tid); continue; } r -= T4;
        { const int e = r / T2; cvtq_tile<1, false>(P.moe_gu + (size_t)e * D * 2 * FF, D, 2 * FF, (unsigned char*)(ws + WS_W_MOE_GU) + (size_t)e * 2 * FF * D, cmax + SW_MOE + e * 2 * FF, sw + SW_MOE + e * 2 * FF, scr, r % T2, tid); }
    }
}
__device__ __forceinline__ float wave_max(float v, int lane) {
    (void)lane;
    v = fmaxf(v, dpp_f<0xB1>(v)); v = fmaxf(v, dpp_f<0x4E>(v)); v = fmaxf(v, dpp_f<0x141>(v)); v = fmaxf(v, dpp_f<0x140>(v));
    return fmaxf(fmaxf(rdl_f(v, 0), rdl_f(v, 16)), fmaxf(rdl_f(v, 32), rdl_f(v, 48)));
}
__device__ __forceinline__ float quant_row_store(const f32x4 (&o)[4], signed char* dst, int lane) {
    float am = 0.f;
#pragma unroll
    for (int j = 0; j < 4; ++j) am = fmaxf(fmaxf(am, fmaxf(fabsf(o[j].x), fabsf(o[j].y))), fmaxf(fabsf(o[j].z), fabsf(o[j].w)));
    am = wave_max(am, lane); const float inv = am > 0.f ? 127.0f / am : 0.f;
    unsigned* d4 = (unsigned*)dst + lane;
#pragma unroll
    for (int j = 0; j < 4; ++j) { const int q0 = (int)__builtin_rintf(o[j].x * inv), q1 = (int)__builtin_rintf(o[j].y * inv), q2 = (int)__builtin_rintf(o[j].z * inv), q3 = (int)__builtin_rintf(o[j].w * inv);
        d4[64 * j] = ((unsigned)q0 & 0xffu) | (((unsigned)q1 & 0xffu) << 8) | (((unsigned)q2 & 0xffu) << 16) | (((unsigned)q3 & 0xffu) << 24); }
    return am * (1.0f / 127.0f);
}
template <bool XBF>
__device__ __forceinline__ void norm_phase(const void* X, const bf16* delta, bf16* X16out, const float* g, const float* msh, const float* ms, signed char* XN, float* SA, int gw, int NGW, int lane) {
    const int wpb = NGW / NB, b = gw / wpb, r0 = gw - b * wpb;
    if (b >= NB) return;
    f32x4 ga[4], hv[4];
    { const f32x4* gp = (const f32x4*)g + lane; const f32x4* sp = (const f32x4*)(ms + (size_t)b * MODW) + lane; const f32x4* hp = (const f32x4*)(msh + (size_t)b * MODW) + lane;
#pragma unroll
      for (int j = 0; j < 4; ++j) { ga[j] = gp[64 * j] * (1.0f + sp[64 * j]); hv[j] = hp[64 * j]; } }
    for (int r = r0; r < SEQ; r += 2 * wpb) {
        int mm[2]; mm[0] = b * SEQ + r; mm[1] = b * SEQ + (r + wpb < SEQ ? r + wpb : r);
        f32x4 v[2][4]; v2u dd[2][4];
#pragma unroll
        for (int q = 0; q < 2; ++q)
#pragma unroll
            for (int j = 0; j < 4; ++j) {
                if (XBF) { const v2u xx = ((const v2u*)((const bf16*)X + (size_t)mm[q] * D) + lane)[64 * j]; v[q][j] = (f32x4){bflo(xx.x), bfhi(xx.x), bflo(xx.y), bfhi(xx.y)}; }
                else v[q][j] = ((const f32x4*)((const float*)X + (size_t)mm[q] * D) + lane)[64 * j];
                if (delta) dd[q][j] = ((const v2u*)(delta + (size_t)mm[q] * D) + lane)[64 * j]; }
#pragma unroll
        for (int q = 0; q < 2; ++q) { const int m = mm[q]; float ss = 0.f;
#pragma unroll
            for (int j = 0; j < 4; ++j) {
                if (delta) { const v2u d2 = dd[q][j]; v[q][j].x += bflo(d2.x); v[q][j].y += bfhi(d2.x); v[q][j].z += bflo(d2.y); v[q][j].w += bfhi(d2.y);
                    v2u w; w.x = pk2(v[q][j].x, v[q][j].y); w.y = pk2(v[q][j].z, v[q][j].w); ((v2u*)(X16out + (size_t)m * D) + lane)[64 * j] = w;
                    v[q][j] = (f32x4){bflo(w.x), bfhi(w.x), bflo(w.y), bfhi(w.y)}; }
                ss += (v[q][j].x * v[q][j].x + v[q][j].y * v[q][j].y) + (v[q][j].z * v[q][j].z + v[q][j].w * v[q][j].w); }
            const float rstd = 1.0f / sqrtf(wave_sum(ss, lane) * (1.0f / D) + EPS);
            f32x4 o[4];
#pragma unroll
            for (int j = 0; j < 4; ++j) o[j] = v[q][j] * rstd * ga[j] + hv[j];
            const float sc = quant_row_store(o, XN + (size_t)m * D, lane);
            if (lane == 0) SA[m] = sc; }
    }
}
typedef short s16x4 __attribute__((ext_vector_type(4)));
typedef short bfx8 __attribute__((ext_vector_type(8)));
__device__ __forceinline__ s16x4 ds_tr(LAS unsigned char* p) { return __builtin_amdgcn_ds_read_tr16_b64_v4i16((LAS s16x4*)p); }
__device__ __forceinline__ bfx8 cat8(s16x4 a, s16x4 b) { return __builtin_shufflevector(a, b, 0, 1, 2, 3, 4, 5, 6, 7); }
__device__ __forceinline__ bfx8 pack8(const f32x4& lo, const f32x4& hi) { v4u w; w.x = pg8::cvt_pk_bf16(lo[0], lo[1]); w.y = pg8::cvt_pk_bf16(lo[2], lo[3]); w.z = pg8::cvt_pk_bf16(hi[0], hi[1]); w.w = pg8::cvt_pk_bf16(hi[2], hi[3]); return __builtin_bit_cast(bfx8, w); }
#define MFMA16(a, b, c) __builtin_amdgcn_mfma_f32_16x16x32_bf16((a), (b), (c), 0, 0, 0)

constexpr int SG_WP = 272, SG_VP = 528, SG_W_OFF = 0, SG_V_OFF = 128 * SG_WP, SG_ST_OFF = SG_V_OFF + 128 * SG_VP;
__device__ __forceinline__ void sgate_mfma(const unsigned char* U, unsigned char* U8, const unsigned char* V, const float2* vstat, const float* lng, const float* lnb, const float* w_s, const float* b_s,
                                           LAS unsigned char* lds, int tid, int bid, int G) {
    const int lane = tid & 63, wave = __builtin_amdgcn_readfirstlane(tid >> 6), l15 = lane & 15, q = lane >> 4;
    LAS unsigned char* Wb = lds + SG_W_OFF; LAS unsigned char* vn = lds + SG_V_OFF; LAS float* st = (LAS float*)(lds + SG_ST_OFF);
    constexpr int NU = (M / CH) * NGRP;
    int gprev = -1;
    f32x4 g0 = {0.f, 0.f, 0.f, 0.f}, g1 = g0, b0 = g0, b1 = g0;
    v2u vraw[8]; f32x4 sraw[4];
#define SG_LOADV(uu_) { const int g_ = (uu_) & 7, n_ = (uu_) >> 3; \
        _Pragma("unroll") for (int i = 0; i < 8; ++i) vraw[i] = *(const v2u*)(V + (size_t)(n_ * CH + (tid >> 5) + 16 * i) * SGW + g_ * 256 + (tid & 31) * 8); \
        const f32x4* sp_ = (const f32x4*)(vstat + (size_t)(n_ * CH + (tid >> 2)) * 32 + (tid & 3) * 8); \
        _Pragma("unroll") for (int i = 0; i < 4; ++i) sraw[i] = sp_[i]; }
    if (bid < NU) SG_LOADV(bid)
    for (int unit = bid; unit < NU; unit += G) {
        const int g = unit & 7, n = unit >> 3;
        __syncthreads();
        if (g != gprev) { gprev = g;
            for (int i = tid; i < CH * CH / 4; i += 512) { const int t = i >> 5, s4 = (i & 31) * 4; f32x4 w = *(const f32x4*)(w_s + (size_t)g * CH * CH + t * CH + s4);
                if (s4 + 0 > t) w.x = 0.f; if (s4 + 1 > t) w.y = 0.f; if (s4 + 2 > t) w.z = 0.f; if (s4 + 3 > t) w.w = 0.f;
                v2u o; o.x = pk2(w.x, w.y); o.y = pk2(w.z, w.w); *(LAS v2u*)(Wb + t * SG_WP + s4 * 2) = o; }
            const int col = g * 256 + (tid & 31) * 8;
            g0 = *(const f32x4*)(lng + col); g1 = *(const f32x4*)(lng + col + 4); b0 = *(const f32x4*)(lnb + col); b1 = *(const f32x4*)(lnb + col + 4); }
        { float sx = (sraw[0].x + sraw[0].z) + (sraw[1].x + sraw[1].z) + (sraw[2].x + sraw[2].z) + (sraw[3].x + sraw[3].z);
          float sq = (sraw[0].y + sraw[0].w) + (sraw[1].y + sraw[1].w) + (sraw[2].y + sraw[2].w) + (sraw[3].y + sraw[3].w);
          sx += dpp_f<0xB1>(sx); sx += dpp_f<0x4E>(sx); sq += dpp_f<0xB1>(sq); sq += dpp_f<0x4E>(sq);
          const float mean = sx * (1.0f / SGW); const float var = sq * (1.0f / SGW) - mean * mean;
          if ((tid & 3) == 0) { st[2 * (tid >> 2)] = mean; st[2 * (tid >> 2) + 1] = 1.0f / sqrtf(var + EPS); } }
        __syncthreads();
#pragma unroll
        for (int i = 0; i < 8; ++i) { const int r = (tid >> 5) + 16 * i, c8 = (tid & 31) * 8;
            const v2u raw = vraw[i]; const float mean = st[2 * r] * V_F8, rstd = st[2 * r + 1] * (1.0f / V_F8);
            const auto f0 = __builtin_amdgcn_cvt_pk_f32_fp8((int)raw.x, false), f1 = __builtin_amdgcn_cvt_pk_f32_fp8((int)raw.x, true), f2 = __builtin_amdgcn_cvt_pk_f32_fp8((int)raw.y, false), f3 = __builtin_amdgcn_cvt_pk_f32_fp8((int)raw.y, true);
            v4u o; o.x = pk2((f0[0] - mean) * rstd * g0.x + b0.x, (f0[1] - mean) * rstd * g0.y + b0.y); o.y = pk2((f1[0] - mean) * rstd * g0.z + b0.z, (f1[1] - mean) * rstd * g0.w + b0.w);
            o.z = pk2((f2[0] - mean) * rstd * g1.x + b1.x, (f2[1] - mean) * rstd * g1.y + b1.y); o.w = pk2((f3[0] - mean) * rstd * g1.z + b1.z, (f3[1] - mean) * rstd * g1.w + b1.w);
            *(LAS v4u*)(vn + r * SG_VP + c8 * 2) = o; }
        unsigned uu[8][2];
#pragma unroll
        for (int T = 0; T < 8; ++T)
#pragma unroll
            for (int ct = 0; ct < 2; ++ct) uu[T][ct] = *(const unsigned*)(U + (size_t)(n * CH + 16 * T + l15) * SGW + g * 256 + 32 * wave + 16 * ct + 4 * q);
        { const int nu = unit + G < NU ? unit + G : unit; SG_LOADV(nu) }
        __syncthreads();
        bfx8 af[4][2];
#pragma unroll
        for (int ks = 0; ks < 4; ++ks)
#pragma unroll
            for (int ct = 0; ct < 2; ++ct) { LAS unsigned char* p0 = vn + (32 * ks + 8 * q + (l15 >> 2)) * SG_VP + (32 * wave + 16 * ct + 4 * (l15 & 3)) * 2; af[ks][ct] = cat8(ds_tr(p0), ds_tr(p0 + 4 * SG_VP)); }
        f32x4 acc[2][8];
#pragma unroll
        for (int T = 0; T < 8; ++T) { acc[0][T] = (f32x4){0.f, 0.f, 0.f, 0.f}; acc[1][T] = (f32x4){0.f, 0.f, 0.f, 0.f};
#pragma unroll
            for (int ks = 0; ks <= T / 2; ++ks) { const bfx8 bfr = *(const LAS bfx8*)(Wb + (16 * T + l15) * SG_WP + (32 * ks + 8 * q) * 2);
                acc[0][T] = MFMA16(af[ks][0], bfr, acc[0][T]); acc[1][T] = MFMA16(af[ks][1], bfr, acc[1][T]); } }
#pragma unroll
        for (int T = 0; T < 8; ++T) { const int t = 16 * T + l15; const float bs = b_s[g * CH + t];
#pragma unroll
            for (int ct = 0; ct < 2; ++ct) { const unsigned u4 = uu[T][ct]; const f32x4 a = acc[ct][T];
                const auto ua = __builtin_amdgcn_cvt_pk_f32_fp8((int)u4, false), ub = __builtin_amdgcn_cvt_pk_f32_fp8((int)u4, true); constexpr float ki = 1.0f / UR_F8;
                *(unsigned*)(U8 + (size_t)(n * CH + t) * SGW + g * 256 + 32 * wave + 16 * ct + 4 * q) = pg8::pk4_fp8(pg8::gelu_f(ua[0] * ki) * (a[0] + bs) * U_F8, pg8::gelu_f(ua[1] * ki) * (a[1] + bs) * U_F8, pg8::gelu_f(ub[0] * ki) * (a[2] + bs) * U_F8, pg8::gelu_f(ub[1] * ki) * (a[3] + bs) * U_F8); } }
    }
#undef SG_LOADV
}

constexpr int RT_PK = 528, RT_PV = 144, RT_KS = 0, RT_VS = 128 * RT_PK, RT_SF = RT_VS + 128 * RT_PV;
static_assert(RT_SF + 32768 <= RING_BYTES, "retention LDS map");
__device__ __forceinline__ void ret_mfma(const bf16* Q, const bf16* Kb, bf16* VO, float* rstat, LAS unsigned char* lds, int tid, int bid, int G) {
    const int lane = tid & 63, wave = __builtin_amdgcn_readfirstlane(tid >> 6), l15 = lane & 15, q = lane >> 4;
    const int tt = wave < 4 ? wave : 11 - wave;
    LAS unsigned char* KS = lds + RT_KS; LAS unsigned char* VS = lds + RT_VS; LAS unsigned char* SF = lds + RT_SF;
    for (int u0 = bid; u0 < NB * RH * 8; u0 += G) {
        const int unit = (G == 256) ? ((u0 & 7) * 32 + (u0 >> 3)) : u0;
        const int b = unit >> 5, h = (unit >> 3) & 3, js = unit & 7;
        const float cd = __builtin_amdgcn_exp2f(128.0f * __builtin_amdgcn_logf(1.0f - __builtin_amdgcn_exp2f(-5.0f - (float)h)));
        f32x4 S[2][4];
#pragma unroll
        for (int ci = 0; ci < 2; ++ci)
#pragma unroll
            for (int vt = 0; vt < 4; ++vt) S[ci][vt] = (f32x4){0.f, 0.f, 0.f, 0.f};
        const char* kbase = (const char*)(Kb + (size_t)(b * SEQ) * D + h * RDK); const char* vbase = (const char*)(VO + (size_t)(b * SEQ) * (RH * RDV) + h * RDV + js * 64);
        const char* qbase = (const char*)(Q + (size_t)(b * SEQ) * D + h * RDK);
        const unsigned koff = (unsigned)((tid >> 5) * D + (tid & 31) * 8) * 2u, voff = (unsigned)((tid >> 3) * (RH * RDV) + (tid & 7) * 8) * 2u, qoff = (unsigned)((16 * tt + l15) * D + 8 * q) * 2u;
        __syncthreads();
#pragma unroll
        for (int i = 0; i < 4; ++i) *(LAS v4u*)(SF + (tid + 512 * i) * 16) = (v4u){0u, 0u, 0u, 0u};
        v4u kr[8], vr[2];
#pragma unroll
        for (int i = 0; i < 8; ++i) kr[i] = *(const v4u*)(kbase + (size_t)i * 16 * D * 2 + koff);
#pragma unroll
        for (int i = 0; i < 2; ++i) vr[i] = *(const v4u*)(vbase + (size_t)i * 64 * (RH * RDV) * 2 + voff);
#pragma unroll
        for (int i = 0; i < 8; ++i) { const int p = tid + 512 * i; *(LAS v4u*)(KS + (p >> 5) * RT_PK + (p & 31) * 16) = kr[i]; }
#pragma unroll
        for (int i = 0; i < 2; ++i) { const int p = tid + 512 * i; *(LAS v4u*)(VS + (p >> 3) * RT_PV + (p & 7) * 16) = vr[i]; }
        bfx8 qf[8];
#pragma unroll
        for (int ks = 0; ks < 8; ++ks) qf[ks] = *(const bfx8*)(qbase + 64 * ks + qoff);
        __syncthreads();
        for (int n = 0; n < SEQ / CH; ++n) {
            const int rowbase = b * SEQ + n * CH;
            const int nn = (n + 1 < SEQ / CH) ? n + 1 : n;
#pragma unroll
            for (int i = 0; i < 8; ++i) kr[i] = *(const v4u*)(kbase + (size_t)(nn * CH + i * 16) * D * 2 + koff);
#pragma unroll
            for (int i = 0; i < 2; ++i) vr[i] = *(const v4u*)(vbase + (size_t)(nn * CH + i * 64) * (RH * RDV) * 2 + voff);
            f32x4 pacc[8];
#pragma unroll
            for (int Si = 0; Si < 8; ++Si) { pacc[Si] = (f32x4){0.f, 0.f, 0.f, 0.f};
                if (Si <= tt) {
                    bfx8 ka[8];
#pragma unroll
                    for (int ks = 0; ks < 8; ++ks) ka[ks] = *(const LAS bfx8*)(KS + (16 * Si + l15) * RT_PK + (32 * ks + 8 * q) * 2);
                    __builtin_amdgcn_sched_barrier(0);
#pragma unroll
                    for (int ks = 0; ks < 8; ++ks) pacc[Si] = MFMA16(ka[ks], qf[ks], pacc[Si]);
                    if (Si == tt) {
#pragma unroll
                        for (int e = 0; e < 4; ++e) if (4 * q + e > l15) pacc[Si][e] = 0.f; } } }
            f32x4 oacc[4];
#pragma unroll
            for (int vt = 0; vt < 4; ++vt) oacc[vt] = (f32x4){0.f, 0.f, 0.f, 0.f};
#pragma unroll
            for (int k2 = 0; k2 < 4; ++k2) { bfx8 sf[2][4];
#pragma unroll
                for (int kq = 0; kq < 2; ++kq)
#pragma unroll
                    for (int vt = 0; vt < 4; ++vt) sf[kq][vt] = *(const LAS bfx8*)(SF + (((2 * k2 + kq) * 4 + vt) * 64 + lane) * 16);
                __builtin_amdgcn_sched_barrier(0);
#pragma unroll
                for (int kq = 0; kq < 2; ++kq)
#pragma unroll
                    for (int vt = 0; vt < 4; ++vt) oacc[vt] = MFMA16(sf[kq][vt], qf[2 * k2 + kq], oacc[vt]);
                __builtin_amdgcn_sched_barrier(0); }
#pragma unroll
            for (int kk = 0; kk < 4; ++kk) if (2 * kk <= tt) { const bfx8 pf = pack8(pacc[2 * kk], pacc[2 * kk + 1]);
                bfx8 vf[4];
#pragma unroll
                for (int vt = 0; vt < 4; ++vt) { LAS unsigned char* p0 = VS + (32 * kk + 4 * q + (l15 >> 2)) * RT_PV + (16 * vt + 4 * (l15 & 3)) * 2; vf[vt] = cat8(ds_tr(p0), ds_tr(p0 + 16 * RT_PV)); }
                __builtin_amdgcn_sched_barrier(0);
#pragma unroll
                for (int vt = 0; vt < 4; ++vt) oacc[vt] = MFMA16(vf[vt], pf, oacc[vt]); }
            { const size_t row = (size_t)(rowbase + 16 * tt + l15); float ss = 0.f;
#pragma unroll
              for (int vt = 0; vt < 4; ++vt) { const f32x4 o = oacc[vt]; ss += (o[0] * o[0] + o[1] * o[1]) + (o[2] * o[2] + o[3] * o[3]);
                  v2u w; w.x = pg8::cvt_pk_bf16(o[0], o[1]); w.y = pg8::cvt_pk_bf16(o[2], o[3]); *(v2u*)(VO + row * (RH * RDV) + h * RDV + js * 64 + 16 * vt + 4 * q) = w; }
              ss += shx(ss, 16, lane); ss += shx(ss, 32, lane);
              if (q == 0) rstat[(row * RH + h) * 8 + js] = ss; }
#pragma unroll
            for (int ks = 0; ks < 8; ++ks) qf[ks] = *(const bfx8*)(qbase + (size_t)(nn * CH) * D * 2 + 64 * ks + qoff);
#pragma unroll
            for (int kk = 0; kk < 4; ++kk) { bfx8 vfn[4];
#pragma unroll
                for (int vt = 0; vt < 4; ++vt) { LAS unsigned char* p0 = VS + (32 * kk + 8 * q + (l15 >> 2)) * RT_PV + (16 * vt + 4 * (l15 & 3)) * 2; vfn[vt] = cat8(ds_tr(p0), ds_tr(p0 + 4 * RT_PV)); }
                bfx8 af[2];
#pragma unroll
                for (int ci = 0; ci < 2; ++ci) { LAS unsigned char* p0 = KS + (32 * kk + 8 * q + (l15 >> 2)) * RT_PK + (32 * wave + 8 * (l15 & 3) + 4 * ci) * 2; af[ci] = cat8(ds_tr(p0), ds_tr(p0 + 4 * RT_PK)); }
                __builtin_amdgcn_sched_barrier(0);
#pragma unroll
                for (int ci = 0; ci < 2; ++ci)
#pragma unroll
                    for (int vt = 0; vt < 4; ++vt) S[ci][vt] = MFMA16(af[ci], vfn[vt], S[ci][vt]);
                __builtin_amdgcn_sched_barrier(0); }
#pragma unroll
            for (int ci = 0; ci < 2; ++ci)
#pragma unroll
                for (int vt = 0; vt < 4; ++vt) S[ci][vt] = S[ci][vt] * cd;
            __syncthreads();
#pragma unroll
            for (int vt = 0; vt < 4; ++vt) *(LAS bfx8*)(SF + ((wave * 4 + vt) * 64 + lane) * 16) = pack8(S[0][vt], S[1][vt]);
#pragma unroll
            for (int i = 0; i < 8; ++i) { const int p = tid + 512 * i; *(LAS v4u*)(KS + (p >> 5) * RT_PK + (p & 31) * 16) = kr[i]; }
#pragma unroll
            for (int i = 0; i < 2; ++i) { const int p = tid + 512 * i; *(LAS v4u*)(VS + (p >> 3) * RT_PV + (p & 7) * 16) = vr[i]; }
            __syncthreads();
        }
    }
}
__device__ __forceinline__ void ognorm_phase(const bf16* O, const bf16* Gs, const float* rstat, signed char* OG8, float* SA, int gw, int NGW, int lane) {
    float stn[2]; v4u ovn[2][RH], gvn[2][RH];
#define OGN_LOAD(mm) _Pragma("unroll") for (int r = 0; r < 2; ++r) { stn[r] = rstat[(size_t)((mm) + r) * (RH * 8) + (lane & 31)]; \
        _Pragma("unroll") for (int h = 0; h < RH; ++h) { const size_t off = (size_t)((mm) + r) * (RH * RDV) + h * RDV + lane * 8; ovn[r][h] = *(const v4u*)(O + off); gvn[r][h] = *(const v4u*)(Gs + off); } }
    OGN_LOAD(2 * gw)
    for (int m0 = 2 * gw; m0 < M; m0 += 2 * NGW) {
        float st[2]; v4u ov[2][RH], gv[2][RH];
#pragma unroll
        for (int r = 0; r < 2; ++r) { st[r] = stn[r];
#pragma unroll
            for (int h = 0; h < RH; ++h) { ov[r][h] = ovn[r][h]; gv[r][h] = gvn[r][h]; } }
        { const int mn = m0 + 2 * NGW < M ? m0 + 2 * NGW : m0; OGN_LOAD(mn) }
#pragma unroll
        for (int r = 0; r < 2; ++r) {
            float s8 = st[r]; s8 += dpp_f<0xB1>(s8); s8 += dpp_f<0x4E>(s8); s8 += dpp_f<0x141>(s8);
            const float rq = 1.0f / sqrtf(s8 * (1.0f / RDV) + EPS);
            float v[RH][8]; float am = 0.f;
#pragma unroll
            for (int h = 0; h < RH; ++h) { const float rr = rdl_f(rq, 8 * h); const v4u o4 = ov[r][h], g4 = gv[r][h];
                v[h][0] = bflo(o4.x) * rr * pg8::silu_f(bflo(g4.x)); v[h][1] = bfhi(o4.x) * rr * pg8::silu_f(bfhi(g4.x)); v[h][2] = bflo(o4.y) * rr * pg8::silu_f(bflo(g4.y)); v[h][3] = bfhi(o4.y) * rr * pg8::silu_f(bfhi(g4.y));
                v[h][4] = bflo(o4.z) * rr * pg8::silu_f(bflo(g4.z)); v[h][5] = bfhi(o4.z) * rr * pg8::silu_f(bfhi(g4.z)); v[h][6] = bflo(o4.w) * rr * pg8::silu_f(bflo(g4.w)); v[h][7] = bfhi(o4.w) * rr * pg8::silu_f(bfhi(g4.w));
#pragma unroll
                for (int e = 0; e < 8; ++e) am = fmaxf(am, fabsf(v[h][e])); }
            am = wave_max(am, lane); const float inv = am > 0.f ? 127.0f / am : 0.f;
#pragma unroll
            for (int h = 0; h < RH; ++h) { unsigned w0 = 0u, w1 = 0u;
#pragma unroll
                for (int e = 0; e < 4; ++e) { const int q0 = (int)__builtin_rintf(v[h][e] * inv), q1 = (int)__builtin_rintf(v[h][4 + e] * inv); w0 |= ((unsigned)q0 & 0xffu) << (8 * e); w1 |= ((unsigned)q1 & 0xffu) << (8 * e); }
                v2u o; o.x = w0; o.y = w1; *(v2u*)(OG8 + (size_t)(m0 + r) * (RH * RDV) + h * RDV + lane * 8) = o; }
            if (lane == 0) SA[m0 + r] = am * (1.0f / 127.0f);
        }
    }
}
__device__ __forceinline__ void route_phase(bf16* X, const bf16* delta, const float* g, const float* msh, const float* ms, const float* wr, const float* br, signed char* XN, float* SA, v4u* route, int* table,
                                            LAS unsigned char* lds, int tid, int lane, int wave, int bid, int G) {
    LAS int* cnt = (LAS int*)lds;
    f32x4 wq[4][4][2], gq[4];
#pragma unroll
    for (int j = 0; j < 4; ++j) { gq[j] = ((const f32x4*)g + lane)[64 * j];
        const f32x4* wp = (const f32x4*)(wr + (size_t)((lane + 64 * j) * 4) * NE);
#pragma unroll
        for (int qq = 0; qq < 4; ++qq) { wq[j][qq][0] = wp[2 * qq]; wq[j][qq][1] = wp[2 * qq + 1]; } }
    for (int blk = bid; blk < M / 128; blk += G) {
        __syncthreads();
        if (tid < 8) cnt[tid] = 0;
        __syncthreads();
        const int b = (blk * 128) / SEQ;
        f32x4 ga[4], hv[4];
        { const f32x4* sp = (const f32x4*)(ms + (size_t)b * MODW) + lane; const f32x4* hp = (const f32x4*)(msh + (size_t)b * MODW) + lane;
#pragma unroll
          for (int j = 0; j < 4; ++j) { ga[j] = gq[j] * (1.0f + sp[64 * j]); hv[j] = hp[64 * j]; } }
        v2u xn[4], dn[4];
#pragma unroll
        for (int j = 0; j < 4; ++j) { const int m0_ = blk * 128 + wave * 16; xn[j] = ((const v2u*)(X + (size_t)m0_ * D) + lane)[64 * j]; dn[j] = ((const v2u*)(delta + (size_t)m0_ * D) + lane)[64 * j]; }
        for (int i = 0; i < 16; ++i) {
            const int m = blk * 128 + wave * 16 + i;
            v2u* xr = (v2u*)(X + (size_t)m * D) + lane;
            f32x4 v[4]; float ss = 0.f;
            v2u xc[4], dc[4];
#pragma unroll
            for (int j = 0; j < 4; ++j) { xc[j] = xn[j]; dc[j] = dn[j]; }
            { const int mn = blk * 128 + wave * 16 + (i < 15 ? i + 1 : i);
#pragma unroll
              for (int j = 0; j < 4; ++j) { xn[j] = ((const v2u*)(X + (size_t)mn * D) + lane)[64 * j]; dn[j] = ((const v2u*)(delta + (size_t)mn * D) + lane)[64 * j]; } }
#pragma unroll
            for (int j = 0; j < 4; ++j) { const v2u xx = xc[j]; const v2u dd = dc[j];
                v2u w; w.x = pk2(bflo(xx.x) + bflo(dd.x), bfhi(xx.x) + bfhi(dd.x)); w.y = pk2(bflo(xx.y) + bflo(dd.y), bfhi(xx.y) + bfhi(dd.y)); xr[64 * j] = w;
                v[j] = (f32x4){bflo(w.x), bfhi(w.x), bflo(w.y), bfhi(w.y)};
                ss += (v[j].x * v[j].x + v[j].y * v[j].y) + (v[j].z * v[j].z + v[j].w * v[j].w); }
            const float rstd = 1.0f / sqrtf(wave_sum(ss, lane) * (1.0f / D) + EPS);
            float lg[NE]; f32x4 oo[4];
#pragma unroll
            for (int e = 0; e < NE; ++e) lg[e] = 0.f;
#pragma unroll
            for (int j = 0; j < 4; ++j) { const f32x4 o = v[j] * rstd * ga[j] + hv[j]; oo[j] = o;
#pragma unroll
                for (int qq = 0; qq < 4; ++qq) { const f32x4 w0 = wq[j][qq][0], w1 = wq[j][qq][1]; const float hk = o[qq];
                    lg[0] += hk * w0.x; lg[1] += hk * w0.y; lg[2] += hk * w0.z; lg[3] += hk * w0.w; lg[4] += hk * w1.x; lg[5] += hk * w1.y; lg[6] += hk * w1.z; lg[7] += hk * w1.w; } }
#pragma unroll
            for (int e = 0; e < NE; ++e) lg[e] = wave_sum(lg[e], lane) + br[e];
            { const float sc = quant_row_store(oo, XN + (size_t)m * D, lane); if (lane == 0) SA[m] = sc; }
            int i1 = 0; float l1 = lg[0];
#pragma unroll
            for (int e = 1; e < NE; ++e) if (lg[e] > l1) { l1 = lg[e]; i1 = e; }
            int i2 = -1; float l2 = -3.0e38f;
#pragma unroll
            for (int e = 0; e < NE; ++e) if (e != i1 && lg[e] > l2) { l2 = lg[e]; i2 = e; }
            const float w1 = 1.0f / (1.0f + __expf(l2 - l1)), w2 = 1.0f - w1;
            if (lane == 0) { v4u r; r.x = (unsigned)i1; r.y = (unsigned)i2; r.z = __builtin_bit_cast(unsigned, w1); r.w = __builtin_bit_cast(unsigned, w2); route[m] = r;
                atomicAdd((int*)(cnt + i1), 1); atomicAdd((int*)(cnt + i2), 1); }
        }
        __syncthreads();
        if (tid < 8) table[blk * 8 + tid] = cnt[tid];
    }
}
__device__ __forceinline__ void sort_phase(const v4u* route, const int* table, const float* SA, unsigned char* listb, LAS unsigned char* lds, int tid, int bid, int G) {
    LAS int* tab = (LAS int*)lds;
    LAS int* ptot = (LAS int*)(lds + 8192);
    LAS int* pmine = (LAS int*)(lds + 8192 + 2048);
    LAS int* tot = (LAS int*)(lds + 8192 + 4096);
    LAS int* ex = (LAS int*)(lds + 8192 + 4096 + 256);
    int* idx = (int*)(listb + LIST_IDX); float* gwt = (float*)(listb + LIST_GW); int* tile_e = (int*)(listb + LIST_TE); int* ntl = (int*)(listb + LIST_NT); float* sal = (float*)(listb + LIST_SAL);
    for (int blk = bid; blk < M / 128; blk += G) {
        __syncthreads();
        for (int i = tid; i < (M / 128) * 8; i += 512) tab[i] = table[i];
        __syncthreads();
        { const int e = tid & 7, part = tid >> 3; int a = 0, mn = 0;
#pragma unroll
          for (int k = 0; k < 4; ++k) { const int bb = part * 4 + k; const int v = tab[bb * 8 + e]; a += v; if (bb < blk) mn += v; }
          ptot[part * 8 + e] = a; pmine[part * 8 + e] = mn; }
        __syncthreads();
        if (tid < 8) { int a = 0, mn = 0; for (int k = 0; k < 64; ++k) { a += ptot[k * 8 + tid]; mn += pmine[k * 8 + tid]; } tot[tid] = a; tot[8 + tid] = mn; }
        v4u r = (v4u){0u, 0u, 0u, 0u};
        if (tid < 128) { r = route[blk * 128 + tid]; ex[tid] = (int)r.x; ex[128 + tid] = (int)r.y; }
        __syncthreads();
        if (tid == 0) { int base = 0; for (int e = 0; e < NE; ++e) { tot[16 + e] = base; const int nt = (tot[e] + 255) >> 8;
                if (blk == 0) for (int k = 0; k < nt; ++k) tile_e[(base >> 8) + k] = e;
                base += nt * 256; }
            if (blk == 0) ntl[0] = base >> 8; }
        if (tid >= 64 && tid < 72) { const int e = tid - 64; int c = 0; for (int k = 0; k < 128; ++k) c += (ex[k] == e) ? 1 : 0; tot[24 + e] = c; }
        __syncthreads();
        if (blk == 0 && tid < 256) { for (int e = 0; e < NE; ++e) { const int n = tot[e], base = tot[16 + e]; const int pos = base + n + tid; if (pos < base + ((n + 255) & ~255)) { idx[pos] = -1; gwt[pos] = 0.f; sal[pos] = 0.f; } } }
        if (tid < 128) { const int e1 = (int)r.x, e2 = (int)r.y; int r1 = 0, r2 = 0;
            for (int k = 0; k < tid; ++k) { r1 += (ex[k] == e1) ? 1 : 0; r2 += (ex[128 + k] == e2) ? 1 : 0; }
            const int p1 = tot[16 + e1] + tot[8 + e1] + r1, p2 = tot[16 + e2] + tot[8 + e2] + tot[24 + e2] + r2; const int tok = blk * 128 + tid;
            const float sat = SA[tok]; idx[p1] = 2 * tok; gwt[p1] = u2f(r.z); sal[p1] = sat; idx[p2] = 2 * tok + 1; gwt[p2] = u2f(r.w); sal[p2] = sat; }
    }
}
__device__ __forceinline__ void final_phase(float* out, const bf16* X16, const bf16* P0, const bf16* P1, const float* g, const float* gate, int gw, int NGW, int lane) {
    const int wpb = NGW / NB, b = gw / wpb, r0 = gw - b * wpb;
    if (b >= NB) return;
    f32x4 gv[4], gt[4];
#pragma unroll
    for (int j = 0; j < 4; ++j) { gv[j] = ((const f32x4*)g + lane)[64 * j]; gt[j] = ((const f32x4*)(gate + (size_t)b * MODW) + lane)[64 * j]; }
    for (int r = r0; r < SEQ; r += 2 * wpb) {
        int mm[2]; mm[0] = b * SEQ + r; mm[1] = b * SEQ + (r + wpb < SEQ ? r + wpb : r);
        v2u x[2][4], a[2][4], c[2][4];
#pragma unroll
        for (int q = 0; q < 2; ++q)
#pragma unroll
            for (int j = 0; j < 4; ++j) { x[q][j] = ((const v2u*)(X16 + (size_t)mm[q] * D) + lane)[64 * j]; a[q][j] = ((const v2u*)(P0 + (size_t)mm[q] * D) + lane)[64 * j]; c[q][j] = ((const v2u*)(P1 + (size_t)mm[q] * D) + lane)[64 * j]; }
#pragma unroll
        for (int q = 0; q < 2; ++q) { f32x4 v[4]; float ss = 0.f;
#pragma unroll
            for (int j = 0; j < 4; ++j) { const v2u xx = x[q][j], aa = a[q][j], bb = c[q][j];
                v[j].x = bflo(xx.x) + gt[j].x * (bflo(aa.x) + bflo(bb.x)); v[j].y = bfhi(xx.x) + gt[j].y * (bfhi(aa.x) + bfhi(bb.x)); v[j].z = bflo(xx.y) + gt[j].z * (bflo(aa.y) + bflo(bb.y)); v[j].w = bfhi(xx.y) + gt[j].w * (bfhi(aa.y) + bfhi(bb.y));
                ss += (v[j].x * v[j].x + v[j].y * v[j].y) + (v[j].z * v[j].z + v[j].w * v[j].w); }
            const float rstd = 1.0f / sqrtf(wave_sum(ss, lane) * (1.0f / D) + EPS);
            f32x4* o = (f32x4*)(out + (size_t)mm[q] * D) + lane;
#pragma unroll
            for (int j = 0; j < 4; ++j) o[64 * j] = v[j] * rstd * gv[j]; }
    }
}

__device__ __forceinline__ const void* karg(int i) { typedef const GAS void* gptr_t; const __attribute__((address_space(4))) gptr_t* ka = (const __attribute__((address_space(4))) gptr_t*)__builtin_amdgcn_kernarg_segment_ptr(); asm volatile("" : "+s"(ka)); return (const void*)ka[i]; }
struct Args { const void* in[22]; float* out; unsigned char* ws; };
__global__ void __launch_bounds__(512, 2) fwd(Args a) {
    extern __shared__ __attribute__((aligned(16))) unsigned char lds_raw[];
    LAS unsigned char* lds = (LAS unsigned char*)lds_raw;
    const int G = gridDim.x, bid = blockIdx.x;
    const int vcu = (G % 8 == 0) ? (bid % 8) * (G / 8) + bid / 8 : bid;
    const int NGW = G * 8;
    const int wave0 = __builtin_amdgcn_readfirstlane((int)threadIdx.x >> 6);
#define FRESH_TID() (wave0 * 64 + fresh_lane())
#define FRESH_IDS() int tid = FRESH_TID(); asm volatile("" : "+v"(tid)); const int lane = tid & 63, wave = wave0; const int gw = vcu * 8 + wave; (void)lane; (void)gw
    unsigned char* const ws0 = a.ws;
#define WS_LOCAL() GAS unsigned char* wsg_ = (GAS unsigned char*)ws0; asm volatile("" : "+s"(wsg_)); unsigned char* ws = (unsigned char*)wsg_
    unsigned char* ws = ws0;
    unsigned* ctl = (unsigned*)(ws + WS_CTL);
    for (int u = threadIdx.x; u < (LDS_BYTES - LDSCTL_OFF) / 4; u += 512) ((LAS unsigned*)(lds + LDSCTL_OFF))[u] = 0u;
    __syncthreads();
    XcdBarrier bar = xcd_barrier_post(ctl + CW_BAR, (volatile LAS unsigned*)(lds + MISC_OFF) + 8);

    float* X = a.out;
    float* MOD = (float*)(ws + WS_MOD);
    signed char* XN = (signed char*)(ws + WS_XN); float* SA = (float*)(ws + WS_SA); const float* SW = (const float*)(ws + WS_SW);
    const float* MOD0 = MOD; const float* MOD1 = MOD + (size_t)NB * MODW;

    { FRESH_IDS(); WS_LOCAL(); mod_phase((const float*)karg(1), (const float*)karg(3), (const float*)karg(4), MOD, lds, tid, lane, wave, bid, G); }
    { FRESH_IDS(); WS_LOCAL(); const WPtrs WP{(const float*)karg(7), (const float*)karg(12), (const float*)karg(13), (const float*)karg(14), (const float*)karg(15), (const float*)karg(16), (const float*)karg(19), (const float*)karg(20)}; cvt_phase_a(WP, ws, lds, gw, NGW, wave, lane); }
    xcd_barrier(bar);
    int vid = bid;
    { volatile LAS unsigned* stw = (volatile LAS unsigned*)(lds + MISC_OFF) + 8;
      if (threadIdx.x == 0) { unsigned ok = (G % 8 == 0) ? 1u : 0u, below = 0u, npop = 0u;
          for (unsigned j = 0; j < 16; ++j) { const unsigned cnt = xb_ld(&ctl[CW_BAR + XB_XCNT(j)]); if (cnt != 0u) { ++npop; if (cnt != (unsigned)G / 8u) ok = 0u; if (j < bar.x) ++below; } }
          if (npop != 8u) ok = 0u;
          stw[3] = ok ? (stw[2] * 8u + below) : (unsigned)bid; }
      __syncthreads();
      vid = __builtin_amdgcn_readfirstlane((int)stw[3]); }
    { FRESH_IDS(); WS_LOCAL(); const WPtrs WP{(const float*)karg(7), (const float*)karg(12), (const float*)karg(13), (const float*)karg(14), (const float*)karg(15), (const float*)karg(16), (const float*)karg(19), (const float*)karg(20)}; cvt_phase_b(WP, ws, lds, bid, G, tid); }
    { FRESH_IDS(); WS_LOCAL(); norm_phase<false>(karg(0), nullptr, nullptr, ((const float*)karg(5)), MOD0 + 0, MOD0 + D, XN, SA, gw, NGW, lane); }
    xcd_barrier(bar);
    { WS_LOCAL(); pg8::Gemm g{(const bf16*)XN, (const bf16*)(ws + WS_W_SGU_IN), D}; pg8::StaticOrder S; S.init(M / 256, 2 * SGW / 256, G, vid, nullptr, nullptr);
      pg8::EpiSguIn E{(unsigned char*)(ws + WS_U), (unsigned char*)(ws + WS_V), (float2*)(ws + WS_VSTAT), SA, SW + SW_SGU};
      pg8::gemm_phase<pg8::EpiSguIn, pg8::StaticOrder, true, false, true>(lds, g, S, E, FRESH_TID()); }
    xcd_barrier(bar);
    { FRESH_IDS(); WS_LOCAL(); sgate_mfma((const unsigned char*)(ws + WS_U), (unsigned char*)(ws + WS_U8), (const unsigned char*)(ws + WS_V), (const float2*)(ws + WS_VSTAT), (const float*)karg(8), (const float*)karg(9), (const float*)karg(10), (const float*)karg(11), lds, tid, bid, G); }
    xcd_barrier(bar);
    { WS_LOCAL(); pg8::Gemm g{(const bf16*)(ws + WS_U8), (const bf16*)(ws + WS_W_SGU_OUT), SGW}; pg8::StaticOrder S; S.init(M / 256, D / 256, G, vid, nullptr, nullptr);
      pg8::EpiDeltaF8 E{(bf16*)(ws + WS_DELTA), MOD0 + 2 * D, SW + SW_SO, 1.0f / U_F8};
      pg8::gemm_phase<pg8::EpiDeltaF8, pg8::StaticOrder, true, false, false, true>(lds, g, S, E, FRESH_TID()); }
    xcd_barrier(bar);
    { FRESH_IDS(); WS_LOCAL(); norm_phase<false>(karg(0), (const bf16*)(ws + WS_DELTA), (bf16*)(ws + WS_X16), ((const float*)karg(6)), MOD0 + 3 * D, MOD0 + 4 * D, XN, SA, gw, NGW, lane); }
    xcd_barrier(bar);
    { WS_LOCAL(); pg8::Gemm g{(const bf16*)XN, (const bf16*)(ws + WS_W_FFN_GU), D}; pg8::StaticOrder S; S.init(M / 256, 2 * FF / 256, G, vid, nullptr, nullptr);
      pg8::EpiSwigluF8 E{(unsigned char*)(ws + WS_ACT), FF, SA, SW + SW_FFN};
      pg8::gemm_phase<pg8::EpiSwigluF8, pg8::StaticOrder, true, false, true>(lds, g, S, E, FRESH_TID()); }
    xcd_barrier(bar);
    { WS_LOCAL(); pg8::Gemm g{(const bf16*)(ws + WS_ACT), (const bf16*)(ws + WS_W_FFN_DN), FF}; pg8::StaticOrder S; S.init(M / 256, D / 256, G, vid, nullptr, nullptr);
      pg8::EpiDeltaF8 E{(bf16*)(ws + WS_DELTA), MOD0 + 5 * D, SW + SW_FD, 1.0f / pg8::ACT_F8};
      pg8::gemm_phase<pg8::EpiDeltaF8, pg8::StaticOrder, true, false, false, true>(lds, g, S, E, FRESH_TID()); }
    xcd_barrier(bar);
    { FRESH_IDS(); WS_LOCAL(); norm_phase<true>(ws + WS_X16, (const bf16*)(ws + WS_DELTA), (bf16*)(ws + WS_X16), ((const float*)karg(5)) + D, MOD1 + 0, MOD1 + D, XN, SA, gw, NGW, lane); }
    xcd_barrier(bar);
    { WS_LOCAL(); pg8::Gemm g{(const bf16*)XN, (const bf16*)(ws + WS_W_RET_IN), D}; pg8::StaticOrder S; S.init(M / 256, RET_IN / 256, G, vid, nullptr, nullptr);
      pg8::EpiRetIn E{(bf16*)(ws + WS_Q), (bf16*)(ws + WS_K), (bf16*)(ws + WS_RV), (bf16*)(ws + WS_G), (const int*)karg(2), SA, SW + SW_RET};
      pg8::gemm_phase<pg8::EpiRetIn, pg8::StaticOrder, true, false, true>(lds, g, S, E, FRESH_TID()); }
    xcd_barrier(bar);
    { FRESH_IDS(); WS_LOCAL(); ret_mfma((const bf16*)(ws + WS_Q), (const bf16*)(ws + WS_K), (bf16*)(ws + WS_RV), (float*)(ws + WS_RSTAT), lds, tid, vid, G); }
    xcd_barrier(bar);
    { FRESH_IDS(); WS_LOCAL(); ognorm_phase((const bf16*)(ws + WS_RV), (const bf16*)(ws + WS_G), (const float*)(ws + WS_RSTAT), (signed char*)(ws + WS_Q), SA, gw, NGW, lane); }
    xcd_barrier(bar);
    { WS_LOCAL(); pg8::Gemm g{(const bf16*)(ws + WS_Q), (const bf16*)(ws + WS_W_RET_OUT), RH * RDV}; pg8::StaticOrder S; S.init(M / 256, D / 256, G, vid, nullptr, nullptr);
      pg8::EpiDelta E{(bf16*)(ws + WS_DELTA), MOD1 + 2 * D, SA, SW + SW_RO};
      pg8::gemm_phase<pg8::EpiDelta, pg8::StaticOrder, true, false, true>(lds, g, S, E, FRESH_TID()); }
    xcd_barrier(bar);
    { FRESH_IDS(); WS_LOCAL(); route_phase((bf16*)(ws + WS_X16), (const bf16*)(ws + WS_DELTA), ((const float*)karg(6)) + D, MOD1 + 3 * D, MOD1 + 4 * D, (const float*)karg(17), (const float*)karg(18), XN, SA, (v4u*)(ws + WS_ROUTE), (int*)(ws + WS_RTAB), lds, tid, lane, wave, bid, G); }
    xcd_barrier(bar);
    { FRESH_IDS(); WS_LOCAL(); sort_phase((const v4u*)(ws + WS_ROUTE), (const int*)(ws + WS_RTAB), SA, ws + WS_LIST, lds, tid, bid, G); }
    xcd_barrier(bar);
    { WS_LOCAL(); const int* idx = (const int*)(ws + WS_LIST + LIST_IDX); const int* tile_e = (const int*)(ws + WS_LIST + LIST_TE); const int ntl = __builtin_amdgcn_readfirstlane(*(const int*)(ws + WS_LIST + LIST_NT));
      pg8::Gemm g{(const bf16*)XN, (const bf16*)(ws + WS_W_MOE_GU), D}; pg8::StaticOrder S; S.init(ntl, 2 * FF / 256, G, vid, tile_e, idx, MOE_WGM);
      pg8::EpiSwigluF8 E{(unsigned char*)(ws + WS_ACT), FF, (const float*)(ws + WS_LIST + LIST_SAL), SW + SW_MOE};
      pg8::gemm_phase<pg8::EpiSwigluF8, pg8::StaticOrder, true, true, true>(lds, g, S, E, FRESH_TID()); }
    xcd_barrier(bar);
    { WS_LOCAL(); const int* idx = (const int*)(ws + WS_LIST + LIST_IDX); const float* gwt = (const float*)(ws + WS_LIST + LIST_GW); const int* tile_e = (const int*)(ws + WS_LIST + LIST_TE); const int ntl = __builtin_amdgcn_readfirstlane(*(const int*)(ws + WS_LIST + LIST_NT));
      pg8::Gemm g{(const bf16*)(ws + WS_ACT), (const bf16*)(ws + WS_W_MOE_DN), FF}; pg8::StaticOrder S; S.init(ntl, D / 256, G, vid, tile_e, nullptr);
      pg8::EpiMoeDown E{(bf16*)(ws + WS_P0), ((long long)WS_P1 - (long long)WS_P0) / 2, idx, gwt, SW + SW_MD, 1.0f / pg8::ACT_F8};
      pg8::gemm_phase<pg8::EpiMoeDown, pg8::StaticOrder, true, false, false, true>(lds, g, S, E, FRESH_TID()); }
    xcd_barrier(bar);
    { FRESH_IDS(); WS_LOCAL(); final_phase(X, (const bf16*)(ws + WS_X16), (const bf16*)(ws + WS_P0), (const bf16*)(ws + WS_P1), (const float*)karg(21), MOD1 + 5 * D, gw, NGW, lane); }
}

extern "C" void kernel_launch(void* const* d_in, const int* in_sizes, int n_in, void* d_out, int out_size, void* d_ws, size_t ws_size, hipStream_t stream) {
    static int grid = 0;
    if (grid == 0) {
        if (n_in != 22 || in_sizes[0] != M * D || out_size != M * D || ws_size < WS_END) { fprintf(stderr, "kernel_launch: unexpected shapes (n_in %d, in0 %d, out %d, ws %zu < %zu)\n", n_in, n_in > 0 ? in_sizes[0] : -1, out_size, ws_size, (size_t)WS_END); grid = -1; return; }
        int dev = 0, cus = 0, per_cu = 0;
        if (hipGetDevice(&dev) != hipSuccess || hipDeviceGetAttribute(&cus, hipDeviceAttributeMultiprocessorCount, dev) != hipSuccess) { grid = -1; return; }
        if (hipFuncSetAttribute((const void*)fwd, hipFuncAttributeMaxDynamicSharedMemorySize, LDS_BYTES) != hipSuccess) { fprintf(stderr, "kernel_launch: hipFuncSetAttribute failed\n"); grid = -1; return; }
        if (hipOccupancyMaxActiveBlocksPerMultiprocessor(&per_cu, (const void*)fwd, 512, LDS_BYTES) != hipSuccess || per_cu < 1) fprintf(stderr, "kernel_launch: occupancy query says %d\n", per_cu);
        (void)hipGetLastError();
        grid = cus;
    }
    if (grid < 0) return;
    if (hipMemsetAsync((char*)d_ws + WS_CTL, 0, CTL_ZERO_BYTES, stream) != hipSuccess) return;
    Args a{};
    for (int i = 0; i < 22; ++i) a.in[i] = d_in[i];
    a.out = (float*)d_out; a.ws = (unsigned char*)d_ws;
    hipLaunchKernelGGL(fwd, dim3(grid), dim3(512), LDS_BYTES, stream, a);
}
```
